# Optimizing an MI355X kernel written in HIP

```python
import math
import jax, jax.numpy as jnp
from jax import lax
import numpy as np

D_MODEL = 1024
BATCH = 16
SEQ = 2048
DEPTH = 4

N_MIXERS = 2
RMS_EPS = 1e-6
FFN_HIDDEN = 2816
Q_BLOCK = 128
NEG = -1e30
MLA_HEADS = 16
MLA_Q_LORA = 384
MLA_KV_LORA = 256
MLA_NOPE = 64
MLA_ROPE = 32
MLA_V = 64
ROPE_THETA = 10000.0
NSA_HEADS = 16
NSA_GROUPS = 4
NSA_QK = 64
NSA_V = 64
CMP_BLOCK = 32
CMP_STRIDE = 16
CMP_HIDDEN = 128
SEL_BLOCK = 64
SEL_TOP_N = 16
WINDOW = 512
SEL_Q_CHUNK = 16
REL_BUCKETS = 32
REL_MAX_DIST = 128

kernel_name = "hybrid_mla_nsa_macaron"


def rmsnorm(x, g):
    x32 = x.astype(jnp.float32)
    y = x32 * lax.rsqrt(jnp.mean(x32 * x32, axis=-1, keepdims=True) + RMS_EPS)
    return y.astype(x.dtype) * g


def swiglu(x, w_gate, w_up, w_down):
    return (jax.nn.silu(x @ w_gate) * (x @ w_up)) @ w_down


def rope_angles(S):
    half = MLA_ROPE // 2
    inv = ROPE_THETA ** (-jnp.arange(half, dtype=jnp.float32) * 2.0 / MLA_ROPE)
    ang = jnp.arange(S, dtype=jnp.float32)[:, None] * inv[None, :]
    return jnp.cos(ang), jnp.sin(ang)


def apply_rotary(x, cos, sin):
    half = x.shape[-1] // 2
    cos = cos.astype(x.dtype)
    sin = sin.astype(x.dtype)
    x1, x2 = x[..., :half], x[..., half:]
    return jnp.concatenate([x1 * cos - x2 * sin, x1 * sin + x2 * cos], axis=-1)


def t5_bucket(dist):
    n = jnp.maximum(dist, 0)
    max_exact = REL_BUCKETS // 2
    nf = jnp.maximum(n, 1).astype(jnp.float32)
    large = max_exact + (jnp.log(nf / max_exact) / math.log(REL_MAX_DIST / max_exact)
                         * (REL_BUCKETS - max_exact)).astype(jnp.int32)
    large = jnp.minimum(large, REL_BUCKETS - 1)
    return jnp.where(n < max_exact, n, large)


def mla_mixer(h, w_in, q_norm, kv_norm, w_uq, w_ukv, w_o):
    B, S, _ = h.shape
    H = MLA_HEADS
    proj = h @ w_in
    c_q = proj[..., :MLA_Q_LORA]
    c_kv = proj[..., MLA_Q_LORA:MLA_Q_LORA + MLA_KV_LORA]
    k_rope = proj[..., MLA_Q_LORA + MLA_KV_LORA:]
    q = (rmsnorm(c_q, q_norm) @ w_uq).reshape(B, S, H, MLA_NOPE + MLA_ROPE)
    kv = (rmsnorm(c_kv, kv_norm) @ w_ukv).reshape(B, S, H, MLA_NOPE + MLA_V)
    cos, sin = rope_angles(S)
    q_nope = q[..., :MLA_NOPE]
    q_rope = apply_rotary(q[..., MLA_NOPE:], cos[:, None, :], sin[:, None, :])
    k_rope = apply_rotary(k_rope, cos, sin)
    k_nope = kv[..., :MLA_NOPE]
    v = kv[..., MLA_NOPE:]
    scale = (MLA_NOPE + MLA_ROPE) ** -0.5
    n_blk = S // Q_BLOCK
    qn_b = q_nope.reshape(B, n_blk, Q_BLOCK, H, MLA_NOPE).swapaxes(0, 1)
    qr_b = q_rope.reshape(B, n_blk, Q_BLOCK, H, MLA_ROPE).swapaxes(0, 1)
    starts = jnp.arange(n_blk) * Q_BLOCK
    kpos = jnp.arange(S)

    def block(args):
        qn, qr, s0 = args
        s = (jnp.einsum('bqhd,bkhd->bhqk', qn, k_nope)
             + jnp.einsum('bqhd,bkd->bhqk', qr, k_rope)).astype(jnp.float32) * scale
        qpos = s0 + jnp.arange(Q_BLOCK)
        p = jax.nn.softmax(jnp.where(kpos[None, :] <= qpos[:, None], s, NEG), axis=-1)
        return jnp.einsum('bhqk,bkhd->bqhd', p.astype(v.dtype), v)

    o = lax.map(block, (qn_b, qr_b, starts)).swapaxes(0, 1).reshape(B, S, H * MLA_V)
    return o @ w_o


def compress_blocks(x, blk_idx, pos_emb, w1, w2):
    B = x.shape[0]
    n_cmp, L = blk_idx.shape
    blocks = x[:, blk_idx] + pos_emb[None, None, :, None, :]
    flat = jnp.moveaxis(blocks, 3, 2).reshape(B, n_cmp, x.shape[2], L * x.shape[3])
    return jax.nn.gelu(flat @ w1) @ w2


def selection_overlap(n_cmp, n_sel):
    cs = np.arange(n_cmp) * CMP_STRIDE
    ce = cs + CMP_BLOCK
    ss = np.arange(n_sel) * SEL_BLOCK
    se = ss + SEL_BLOCK
    ov = np.minimum(ce[:, None], se[None, :]) - np.maximum(cs[:, None], ss[None, :])
    return (np.clip(ov, 0, None) / CMP_BLOCK).astype(np.float32)


def selected_attention(q, k, v, sel_idx, tbl, scale):
    B, S, G, R, dk = q.shape
    dv = v.shape[-1]
    n_sel = S // SEL_BLOCK
    n_top = sel_idx.shape[-1]
    kb = k.reshape(B, n_sel, SEL_BLOCK, G, dk).transpose(0, 3, 1, 2, 4)
    vb = v.reshape(B, n_sel, SEL_BLOCK, G, dv).transpose(0, 3, 1, 2, 4)
    C = SEL_Q_CHUNK
    n_ch = S // C
    q_ch = q.reshape(B, n_ch, C, G, R, dk).swapaxes(0, 1)
    idx_ch = sel_idx.reshape(B, G, n_ch, C, n_top).transpose(2, 0, 1, 3, 4)
    starts = jnp.arange(n_ch) * C
    gather = jax.vmap(jax.vmap(lambda blocks, ix: blocks[ix]))
    g_ar = jnp.arange(G)[None, :, None, None]
    K = n_top * SEL_BLOCK

    def chunk(args):
        q_i, ix, s0 = args
        kg = gather(kb, ix).reshape(B, G, C, K, dk)
        vg = gather(vb, ix).reshape(B, G, C, K, dv)
        kpos = (ix[..., None] * SEL_BLOCK + jnp.arange(SEL_BLOCK)).reshape(B, G, C, K)
        qpos = s0 + jnp.arange(C)
        dist = qpos[None, None, :, None] - kpos
        bias = tbl[t5_bucket(dist), g_ar]
        s = jnp.einsum('bcgrd,bgckd->bgcrk', q_i, kg).astype(jnp.float32) * scale \
            + jnp.moveaxis(bias, -1, 3).astype(jnp.float32)
        p = jax.nn.softmax(jnp.where((dist >= 0)[:, :, :, None, :], s, NEG), axis=-1)
        return jnp.einsum('bgcrk,bgckd->bcgrd', p.astype(vg.dtype), vg)

    out = lax.map(chunk, (q_ch, idx_ch, starts))
    return out.swapaxes(0, 1).reshape(B, S, G, R, dv)


def window_attention(q, k, v, tbl, scale):
    B, S, G, R, dk = q.shape
    n_blk = S // Q_BLOCK
    span = WINDOW + Q_BLOCK
    k_pad = jnp.pad(k, ((0, 0), (WINDOW, 0), (0, 0), (0, 0)))
    v_pad = jnp.pad(v, ((0, 0), (WINDOW, 0), (0, 0), (0, 0)))
    q_b = q.reshape(B, n_blk, Q_BLOCK, G, R, dk).swapaxes(0, 1)
    starts = jnp.arange(n_blk) * Q_BLOCK

    def block(args):
        q_i, s0 = args
        k_i = lax.dynamic_slice_in_dim(k_pad, s0, span, axis=1)
        v_i = lax.dynamic_slice_in_dim(v_pad, s0, span, axis=1)
        qpos = s0 + jnp.arange(Q_BLOCK)
        kpos = s0 - WINDOW + jnp.arange(span)
        dist = qpos[:, None] - kpos[None, :]
        mask = (dist >= 0) & (dist < WINDOW) & (kpos >= 0)[None, :]
        bias = tbl[t5_bucket(dist)].transpose(2, 3, 0, 1)
        s = jnp.einsum('bqgrd,bkgd->bgrqk', q_i, k_i).astype(jnp.float32) * scale + bias.astype(jnp.float32)
        p = jax.nn.softmax(jnp.where(mask, s, NEG), axis=-1)
        return jnp.einsum('bgrqk,bkgd->bqgrd', p.astype(v_i.dtype), v_i)

    out = lax.map(block, (q_b, starts))
    return out.swapaxes(0, 1).reshape(B, S, G, R, v.shape[-1])


def nsa_mixer(h, rel_bias, w_in, pos_k, w1_k, w2_k, pos_v, w1_v, w2_v, w_o):
    B, S, _ = h.shape
    H, G = NSA_HEADS, NSA_GROUPS
    R = H // G
    sizes = [H * NSA_QK, G * NSA_QK, G * NSA_V, G * NSA_QK, G * NSA_V, G * NSA_QK, G * NSA_V, H * 3]
    cuts = [int(c) for c in np.cumsum(sizes[:-1])]
    q, k_c, v_c, k_s, v_s, k_w, v_w, g = jnp.split(h @ w_in, cuts, axis=-1)
    q = q.reshape(B, S, G, R, NSA_QK)
    k_c, k_s, k_w = (t.reshape(B, S, G, NSA_QK) for t in (k_c, k_s, k_w))
    v_c, v_s, v_w = (t.reshape(B, S, G, NSA_V) for t in (v_c, v_s, v_w))
    gates = jax.nn.sigmoid(g.astype(jnp.float32)).astype(h.dtype).reshape(B, S, G, R, 3)
    tbl = rel_bias.reshape(REL_BUCKETS, G, R)
    scale = NSA_QK ** -0.5
    pos = jnp.arange(S)

    n_cmp = (S - CMP_BLOCK) // CMP_STRIDE + 1
    blk_idx = jnp.arange(n_cmp)[:, None] * CMP_STRIDE + jnp.arange(CMP_BLOCK)[None, :]
    kc = compress_blocks(k_c, blk_idx, pos_k, w1_k, w2_k)
    vc = compress_blocks(v_c, blk_idx, pos_v, w1_v, w2_v)
    cmp_end = jnp.arange(n_cmp) * CMP_STRIDE + CMP_BLOCK - 1
    dist = pos[:, None] - cmp_end[None, :]
    valid = dist >= 0
    bias = tbl[t5_bucket(dist)].transpose(2, 3, 0, 1)
    s = jnp.einsum('bsgrd,bngd->bgrsn', q, kc).astype(jnp.float32) * scale + bias.astype(jnp.float32)
    p_cmp = jax.nn.softmax(jnp.where(valid, s, NEG), axis=-1) * valid
    o_cmp = jnp.einsum('bgrsn,bngd->bsgrd', p_cmp.astype(vc.dtype), vc)

    n_sel = S // SEL_BLOCK
    overlap = jnp.asarray(selection_overlap(n_cmp, n_sel))
    imp = jnp.einsum('bgrsn,nj->bgsj', p_cmp, overlap)
    blk_t = (pos // SEL_BLOCK)[:, None]
    j = jnp.arange(n_sel)[None, :]
    forced = (j == 0) | (j == blk_t) | (j == blk_t - 1)
    score = jnp.where(forced, 1e6, jnp.where(j <= blk_t, imp, -1e6))
    n_top = min(SEL_TOP_N, n_sel)
    _, sel_idx = lax.top_k(score, n_top)
    o_sel = selected_attention(q, k_s, v_s, sel_idx, tbl, scale)

    o_win = window_attention(q, k_w, v_w, tbl, scale)

    o = gates[..., 0:1] * o_cmp + gates[..., 1:2] * o_sel + gates[..., 2:3] * o_win
    return o.reshape(B, S, H * NSA_V) @ w_o


def setup_inputs(seed: int = 0) -> dict:
    key = jax.random.key(seed)
    ks = iter(jax.random.split(key, 32))
    n_mla = len(range(0, DEPTH, N_MIXERS))
    n_nsa = DEPTH - n_mla

    def dense(shape, fan_in):
        return jax.random.normal(next(ks), shape, jnp.float32) * fan_in ** -0.5

    def gain(shape):
        return 1.0 + 0.01 * jax.random.normal(next(ks), shape, jnp.float32)

    def small(shape, s):
        return s * jax.random.normal(next(ks), shape, jnp.float32)

    mla_in = MLA_Q_LORA + MLA_KV_LORA + MLA_ROPE
    nsa_in = NSA_HEADS * NSA_QK + 3 * NSA_GROUPS * (NSA_QK + NSA_V) + 3 * NSA_HEADS
    return {
        "x": jax.random.normal(next(ks), (BATCH, SEQ, D_MODEL), jnp.float32),
        "ffn_norm_a": gain((DEPTH, D_MODEL)),
        "ffn_a_w_gate": dense((DEPTH, D_MODEL, FFN_HIDDEN), D_MODEL),
        "ffn_a_w_up": dense((DEPTH, D_MODEL, FFN_HIDDEN), D_MODEL),
        "ffn_a_w_down": dense((DEPTH, FFN_HIDDEN, D_MODEL), FFN_HIDDEN),
        "mix_norm": gain((DEPTH, D_MODEL)),
        "ffn_norm_b": gain((DEPTH, D_MODEL)),
        "ffn_b_w_gate": dense((DEPTH, D_MODEL, FFN_HIDDEN), D_MODEL),
        "ffn_b_w_up": dense((DEPTH, D_MODEL, FFN_HIDDEN), D_MODEL),
        "ffn_b_w_down": dense((DEPTH, FFN_HIDDEN, D_MODEL), FFN_HIDDEN),
        "final_norm": gain((D_MODEL,)),
        "rel_bias": small((REL_BUCKETS, NSA_HEADS), 0.5),
        "mla_w_in": dense((n_mla, D_MODEL, mla_in), D_MODEL),
        "mla_q_norm": gain((n_mla, MLA_Q_LORA)),
        "mla_kv_norm": gain((n_mla, MLA_KV_LORA)),
        "mla_w_uq": dense((n_mla, MLA_Q_LORA, MLA_HEADS * (MLA_NOPE + MLA_ROPE)), MLA_Q_LORA),
        "mla_w_ukv": dense((n_mla, MLA_KV_LORA, MLA_HEADS * (MLA_NOPE + MLA_V)), MLA_KV_LORA),
        "mla_w_o": dense((n_mla, MLA_HEADS * MLA_V, D_MODEL), MLA_HEADS * MLA_V),
        "nsa_w_in": dense((n_nsa, D_MODEL, nsa_in), D_MODEL),
        "nsa_cmp_pos_k": small((n_nsa, CMP_BLOCK, NSA_QK), 0.1),
        "nsa_cmp_w1_k": dense((n_nsa, CMP_BLOCK * NSA_QK, CMP_HIDDEN), CMP_BLOCK * NSA_QK),
        "nsa_cmp_w2_k": dense((n_nsa, CMP_HIDDEN, NSA_QK), CMP_HIDDEN),
        "nsa_cmp_pos_v": small((n_nsa, CMP_BLOCK, NSA_V), 0.1),
        "nsa_cmp_w1_v": dense((n_nsa, CMP_BLOCK * NSA_V, CMP_HIDDEN), CMP_BLOCK * NSA_V),
        "nsa_cmp_w2_v": dense((n_nsa, CMP_HIDDEN, NSA_V), CMP_HIDDEN),
        "nsa_w_o": dense((n_nsa, NSA_HEADS * NSA_V, D_MODEL), NSA_HEADS * NSA_V),
    }


def reference(x, ffn_norm_a, ffn_a_w_gate, ffn_a_w_up, ffn_a_w_down, mix_norm, ffn_norm_b,
              ffn_b_w_gate, ffn_b_w_up, ffn_b_w_down, final_norm, rel_bias,
              mla_w_in, mla_q_norm, mla_kv_norm, mla_w_uq, mla_w_ukv, mla_w_o,
              nsa_w_in, nsa_cmp_pos_k, nsa_cmp_w1_k, nsa_cmp_w2_k,
              nsa_cmp_pos_v, nsa_cmp_w1_v, nsa_cmp_w2_v, nsa_w_o):
    h = x
    for i in range(DEPTH):
        h = h + 0.5 * swiglu(rmsnorm(h, ffn_norm_a[i]), ffn_a_w_gate[i], ffn_a_w_up[i], ffn_a_w_down[i])
        m = rmsnorm(h, mix_norm[i])
        j = i // N_MIXERS
        if i % N_MIXERS == 0:
            h = h + mla_mixer(m, mla_w_in[j], mla_q_norm[j], mla_kv_norm[j],
                              mla_w_uq[j], mla_w_ukv[j], mla_w_o[j])
        else:
            h = h + nsa_mixer(m, rel_bias, nsa_w_in[j], nsa_cmp_pos_k[j], nsa_cmp_w1_k[j], nsa_cmp_w2_k[j],
                              nsa_cmp_pos_v[j], nsa_cmp_w1_v[j], nsa_cmp_w2_v[j], nsa_w_o[j])
        h = h + 0.5 * swiglu(rmsnorm(h, ffn_norm_b[i]), ffn_b_w_gate[i], ffn_b_w_up[i], ffn_b_w_down[i])
    return rmsnorm(h, final_norm)
```

```cpp
#include <hip/hip_runtime.h>
#include <hip/hip_cooperative_groups.h>
#include <cstdio>
#include <cstdint>
namespace cg = cooperative_groups;

#ifndef MK_PER_PHASE
#define MK_PER_PHASE 0
#endif
#ifndef PROBE_VARIANT
#define PROBE_VARIANT 0
#endif
#ifndef PROBE_MASK
#define PROBE_MASK 0
#endif

#define DI __device__ __forceinline__
#define LAS __attribute__((address_space(3)))
typedef unsigned short bf16_t;
typedef short bf16x8 __attribute__((ext_vector_type(8)));
typedef float f32x4 __attribute__((ext_vector_type(4)));
typedef float f32x16 __attribute__((ext_vector_type(16)));
typedef unsigned u32x4 __attribute__((ext_vector_type(4)));
typedef unsigned u32x2 __attribute__((ext_vector_type(2)));

constexpr int M = 32768, D = 1024, FF = 2816, SEQ = 2048, NB = 16;
constexpr float LOG2E = 1.4426950408889634f;
constexpr float NEGF = -1e30f;
constexpr float EPS = 1e-6f;
constexpr int LDS_GEMM = 131072;
constexpr int LDS_RS = LDS_GEMM + 16;
constexpr int LDS_BYTES = LDS_RS + 512 * 32;

constexpr size_t MiB = (size_t)1 << 20;
constexpr size_t WS_ROPE = 0;
constexpr size_t WS_C1 = 512 * 1024;
constexpr size_t WS_BAR = 768 * 1024;
constexpr size_t WS_SS = 1 * MiB;
constexpr size_t WS_SSQ = 3 * MiB;
constexpr size_t WS_HB = 5 * MiB;
constexpr size_t WS_W = 69 * MiB;
constexpr size_t WS_BIG = 230 * MiB;
constexpr size_t WS_KR = WS_BIG + 274 * MiB;
constexpr size_t WS_END = WS_KR + 2 * MiB;
constexpr int VPITCH = 2048 + 64;
constexpr size_t FFN_WGU = 0, FFN_WD = (size_t)5632 * 1024, FFN_SZ = FFN_WD + (size_t)1024 * 2816;
constexpr size_t W_MLA = 8 * FFN_SZ;
constexpr size_t MLA_WIN = 0, MLA_WUQ = MLA_WIN + 768 * 1024, MLA_WUKV = MLA_WUQ + 1536 * 384, MLA_WO = MLA_WUKV + 2048 * 256, MLA_SZ = MLA_WO + 1024 * 1024;
constexpr size_t W_NSA = W_MLA + 2 * MLA_SZ;
constexpr size_t NSA_WIN = 0, NSA_W1K = NSA_WIN + 2816 * 1024, NSA_W1V = NSA_W1K + 128 * 2048, NSA_W2K = NSA_W1V + 128 * 2048, NSA_W2V = NSA_W2K + 64 * 128, NSA_WO = NSA_W2V + 64 * 128, NSA_SZ = NSA_WO + 1024 * 1024;
static_assert((W_NSA + 2 * NSA_SZ) * 2 <= 161 * MiB, "weights region");
static_assert((size_t)16 * 1024 * (2048 + 64) * 2 <= 66 * MiB && (size_t)16 * 512 * (2048 + 64) * 2 <= 33 * MiB, "V^T regions");
constexpr size_t B_HID = 0;
constexpr size_t B_CQKV = 0, B_MQ = 48 * MiB, B_VT = 144 * MiB  , B_O = 210 * MiB;
constexpr size_t B_NQ = 0, B_SLAB = 64 * MiB  , B_VT2 = 128 * MiB  , B_GATES = 161 * MiB, B_KCMP = 168 * MiB, B_VCMPT = 169 * MiB;
constexpr size_t SLAB_EL = (size_t)M * 256;

DI unsigned pk2(float lo, float hi) {
    typedef __bf16 bf2 __attribute__((ext_vector_type(2)));
    bf2 v; v[0] = (__bf16)lo; v[1] = (__bf16)hi; return __builtin_bit_cast(unsigned, v);
}
DI u32x4 pk8(f32x4 a, f32x4 b) { u32x4 o; o.x = pk2(a.x, a.y); o.y = pk2(a.z, a.w); o.z = pk2(b.x, b.y); o.w = pk2(b.z, b.w); return o; }
DI int opaque_tid(int wv) { unsigned ones = ~0u; asm volatile("" : "+s"(ones)); int t = wv * 64 + (int)__builtin_amdgcn_mbcnt_hi(ones, __builtin_amdgcn_mbcnt_lo(ones, 0u)); asm volatile("" : "+v"(t)); return t; }
DI int opaque_tid_full() { return (int)threadIdx.x; }
DI int launder_v(int v) { asm volatile("" : "+v"(v)); return v; }
DI float fexp2(float x) { return __builtin_amdgcn_exp2f(x); }
DI float frcp(float x) { return __builtin_amdgcn_rcpf(x); }
DI float sigmoidf_(float x) { return frcp(1.f + fexp2(-x * LOG2E)); }
template <int STRIDE, int P0, int NP4>
DI float rstd_parts(const float* parts, size_t row, float invK) {
    const f32x4* p = (const f32x4*)(parts + row * STRIDE + P0); float s = 0.f;
#pragma unroll
    for (int i = 0; i < NP4; ++i) { f32x4 v = p[i]; s += (v.x + v.y) + (v.z + v.w); }
    return rsqrtf(s * invK + EPS);
}
#define EPI_SCHED() __builtin_amdgcn_sched_barrier(0)

namespace pg8 {
constexpr int BM = 256, BK = 64, HALF = 128, HTB = HALF * BK * 2, STAGE_BYTES = 8 * HTB, NXCD = 8, WGM = 8;
__host__ __device__ __forceinline__ int lds_byte(int r, int c) { const int st = (r >> 4) * 2 + (c >> 5), rr = r & 15, cc = c & 31, ob = rr * 64 + cc * 2; return st * 1024 + (ob ^ (((ob >> 9) & 1) << 5)); }
__host__ __device__ __forceinline__ void stage_rc(int b, int& R, int& C) { const int st = b / 1024, sb = b % 1024, swz = sb ^ (((sb >> 9) & 1) << 5); R = (st >> 1) * 16 + swz / 64; C = (st & 1) * 32 + (swz % 64) / 2; }
__host__ __device__ __forceinline__ int perm32(int rho) { const int n = rho >> 4, i = rho & 15; return 8 * (i >> 2) + 4 * n + (i & 3); }
struct Unit { int pm, pn; };
struct Gemm { const bf16_t* A; const bf16_t* Bt; int M, N, K, lda, ldb; };
template <int NM, int NN>
struct StaticOrder {
    static constexpr int nM = NM, nN = NN, nwg = NM * NN;
    int G, c;
    DI void init(int, int, int G_, int c_) { G = G_; c = c_; }
    DI bool next(int i, Unit& u) const {
        const int L = i * G + c; if (L >= nwg) return false;
        int wgid = L; { constexpr int q = nwg / NXCD, r = nwg % NXCD; const int xcd = wgid % NXCD, off = wgid / NXCD; wgid = (xcd < r ? xcd * (q + 1) : r * (q + 1) + (xcd - r) * q) + off; }
        constexpr int nig = WGM * nN; const int gid = wgid / nig, fm = gid * WGM, gsz = (nM - fm) < WGM ? (nM - fm) : WGM;
        u.pm = fm + ((wgid % nig) % gsz); u.pn = (wgid % nig) / gsz; return true;
    }
};
template <class T, class = void> struct epi_prefetch { static constexpr bool value = false; };
template <class T> struct epi_prefetch<T, decltype((void)T::PREFETCH)> { static constexpr bool value = T::PREFETCH; };
template <class Epi, class Sched>
DI void gemm_phase(int wv, LAS unsigned char* lds, const Gemm g, const Sched& S, const Epi& E) {
    const int tid = opaque_tid(wv), wid = __builtin_amdgcn_readfirstlane(tid >> 6), lane = tid & 63, wr = wid >> 2, wc = wid & 3, fr = lane & 15, fq = lane >> 4;
    const int K = g.K, nt = K / BK;
    unsigned voffA[2], voffB[2];
#pragma unroll
    for (int i = 0; i < 2; ++i) { int R, C; stage_rc(tid * 16 + i * 8192, R, C); const int Rb = (R & ~31) + perm32(R & 31);
        voffA[i] = (unsigned)(R * g.lda + C) * 2u; voffB[i] = (unsigned)(Rb * g.ldb + C) * 2u; }
    const size_t kstep = (size_t)(BK * 2);
    const size_t hstepA = (size_t)HALF * g.lda * 2, hstepB = (size_t)HALF * g.ldb * 2;
    const size_t tstepA = 2 * hstepA, tstepB = 2 * hstepB;
    const unsigned ldsw = (unsigned)wid * 1024u;
    const int aoff = lds_byte(wr * 64 + fr, fq * 8), boff = lds_byte(wc * 32 + fr, fq * 8);
#define PG8_SA(b, h) (((b) * 2 + (h)) * HTB)
#define PG8_SB(b, h) ((4 + (b) * 2 + (h)) * HTB)
#define PG8_STAGE(bufoff, gbase, voff) do { const char* _gb = (const char*)(gbase); asm volatile("" : "+s"(_gb)); _Pragma("unroll") for (int _i = 0; _i < 2; ++_i) { \
        unsigned _vo = (voff)[_i]; asm volatile("" : "+v"(_vo));     \
        __builtin_amdgcn_global_load_lds((const unsigned*)(_gb + _vo), (LAS unsigned*)(lds + (bufoff) + ldsw + _i * 8192), 16, 0, 0); } } while (0)
#define PG8_LDA(dst, b, h) do { _Pragma("unroll") for (int m = 0; m < 4; ++m) _Pragma("unroll") for (int k = 0; k < 2; ++k) dst[m][k] = *(const LAS bf16x8*)(lds + PG8_SA(b, h) + aoff + m * 2048 + k * 1024); } while (0)
#define PG8_LDB(dst, b, h) do { _Pragma("unroll") for (int n = 0; n < 2; ++n) _Pragma("unroll") for (int k = 0; k < 2; ++k) dst[n][k] = *(const LAS bf16x8*)(lds + PG8_SB(b, h) + boff + n * 2048 + k * 1024); } while (0)
#define PG8_MMA(ai, bj, At, Bt) do { __builtin_amdgcn_s_setprio(1); _Pragma("unroll") for (int m = 0; m < 4; ++m) _Pragma("unroll") for (int n = 0; n < 2; ++n) _Pragma("unroll") for (int k = 0; k < 2; ++k) \
        acc[ai][bj][m][n] = __builtin_amdgcn_mfma_f32_16x16x32_bf16(Bt[n][k], At[m][k], acc[ai][bj][m][n], 0, 0, 0); __builtin_amdgcn_s_setprio(0); } while (0)
#define PG8_WAIT_V(n) asm volatile("s_waitcnt vmcnt(" #n ")" ::: "memory")
#define PG8_WAIT_L(n) asm volatile("s_waitcnt lgkmcnt(" #n ")" ::: "memory")
#define PG8_BAR __builtin_amdgcn_s_barrier()
#define PG8_SCHED __builtin_amdgcn_sched_barrier(0)
    Unit cur, nxt; int ui = 0;
    if (!S.next(0, cur)) return;
    f32x4 acc[2][2][4][2];
#pragma unroll
    for (int a = 0; a < 2; ++a)
#pragma unroll
        for (int b = 0; b < 2; ++b)
#pragma unroll
            for (int m = 0; m < 4; ++m)
#pragma unroll
                for (int n = 0; n < 2; ++n) acc[a][b][m][n] = (f32x4){0.f, 0.f, 0.f, 0.f};
    bf16x8 At[4][2], B0[2][2], B1[2][2];
    const char* cA = (const char*)g.A + (size_t)cur.pm * tstepA; const char* cB = (const char*)g.Bt + (size_t)cur.pn * tstepB;
    float rsn[2][4];
    if constexpr (epi_prefetch<Epi>::value) E.pre(cur, wr, wc, fr, fq, rsn);
    PG8_STAGE(PG8_SB(0, 0), cB, voffB); PG8_STAGE(PG8_SB(0, 1), cB + hstepB, voffB); PG8_STAGE(PG8_SA(0, 0), cA, voffA); PG8_STAGE(PG8_SA(0, 1), cA + hstepA, voffA);
    if (wr == 1) PG8_BAR;
    PG8_WAIT_V(2); PG8_BAR;
    PG8_STAGE(PG8_SB(1, 0), cB + kstep, voffB); PG8_STAGE(PG8_SA(1, 0), cA + kstep, voffA); PG8_STAGE(PG8_SB(1, 1), cB + hstepB + kstep, voffB);
    PG8_WAIT_V(6); PG8_BAR;
    for (;;) {
        const bool has_next = S.next(ui + 1, nxt);
        const char* nA = has_next ? (const char*)g.A + (size_t)nxt.pm * tstepA : cA; const char* nB = has_next ? (const char*)g.Bt + (size_t)nxt.pn * tstepB : cB;
#pragma nounroll
        for (int t = 0; t < nt; t += 2) {
            const bool last = (t == nt - 2);
            const char* a1 = cA + (size_t)(t + 1) * kstep;
            const char* a2 = last ? nA : cA + (size_t)(t + 2) * kstep; const char* b2 = last ? nB : cB + (size_t)(t + 2) * kstep;
            const char* a3 = a2 + kstep; const char* b3 = b2 + kstep;
            PG8_LDB(B0, 0, 0); PG8_LDB(B1, 0, 1); PG8_SCHED; PG8_LDA(At, 0, 0); PG8_STAGE(PG8_SA(1, 1), a1 + hstepA, voffA);
            PG8_WAIT_V(8); PG8_WAIT_L(0); PG8_BAR; PG8_MMA(0, 0, At, B0); PG8_MMA(0, 1, At, B1); PG8_BAR; PG8_SCHED;
            PG8_LDA(At, 0, 1); PG8_STAGE(PG8_SB(0, 0), b2, voffB); PG8_STAGE(PG8_SB(0, 1), b2 + hstepB, voffB); PG8_STAGE(PG8_SA(0, 0), a2, voffA);
            PG8_WAIT_V(8); PG8_WAIT_L(0); PG8_BAR; PG8_MMA(1, 0, At, B0); PG8_MMA(1, 1, At, B1); PG8_BAR; PG8_SCHED;
            PG8_LDB(B0, 1, 0); PG8_LDB(B1, 1, 1); PG8_SCHED; PG8_LDA(At, 1, 0); PG8_STAGE(PG8_SA(0, 1), a2 + hstepA, voffA);
            PG8_WAIT_V(8); PG8_WAIT_L(0); PG8_BAR; PG8_MMA(0, 0, At, B0); PG8_MMA(0, 1, At, B1); PG8_BAR; PG8_SCHED;
            PG8_LDA(At, 1, 1); PG8_STAGE(PG8_SB(1, 0), b3, voffB); PG8_STAGE(PG8_SB(1, 1), b3 + hstepB, voffB); PG8_STAGE(PG8_SA(1, 0), a3, voffA);
            PG8_WAIT_V(8); PG8_WAIT_L(0); PG8_BAR; PG8_MMA(1, 0, At, B0); PG8_MMA(1, 1, At, B1); PG8_BAR; PG8_SCHED;
        }
        PG8_SCHED;
        if (wr == 0) PG8_BAR;
        { const int l2 = opaque_tid(0);
          if constexpr (epi_prefetch<Epi>::value) E(acc, cur, nxt, has_next, wr, wc, l2 & 15, l2 >> 4, rsn); else E(acc, cur, wr, wc, l2 & 15, l2 >> 4); }
        if (!has_next) break;
#pragma unroll
        for (int a = 0; a < 2; ++a)
#pragma unroll
            for (int b = 0; b < 2; ++b)
#pragma unroll
                for (int m = 0; m < 4; ++m)
#pragma unroll
                    for (int n = 0; n < 2; ++n) acc[a][b][m][n] = (f32x4){0.f, 0.f, 0.f, 0.f};
        cur = nxt; cA = nA; cB = nB; ++ui;
        if (wr == 1) PG8_BAR;
    }
    PG8_WAIT_V(0);
    PG8_BAR;
#undef PG8_SA
#undef PG8_SB
#undef PG8_STAGE
#undef PG8_LDA
#undef PG8_LDB
#undef PG8_MMA
#undef PG8_WAIT_V
#undef PG8_WAIT_L
#undef PG8_BAR
#undef PG8_SCHED
}
}
using pg8::Unit;
typedef f32x4 AccT[2][2][4][2];

template <int STRIDE, int P0, int NP4>
DI void rstd8(const float* parts, size_t row0, float invK, int fq, float (&rs)[2][4]) {
    f32x4 v[2][4];
#pragma unroll
    for (int ai = 0; ai < 2; ++ai)
#pragma unroll
        for (int m = 0; m < 4; ++m) {
            const float* p = parts + (row0 + ai * 128 + m * 16) * STRIDE + P0;
            if (NP4 == 1) v[ai][m] = *(const f32x4*)p;
            else if (fq < NP4) v[ai][m] = *(const f32x4*)(p + 4 * fq);
            else v[ai][m] = (f32x4){0.f, 0.f, 0.f, 0.f};
        }
#pragma unroll
    for (int ai = 0; ai < 2; ++ai)
#pragma unroll
        for (int m = 0; m < 4; ++m) {
            float t = (v[ai][m].x + v[ai][m].y) + (v[ai][m].z + v[ai][m].w);
            if (NP4 > 1) { t += __shfl_xor(t, 16); t += __shfl_xor(t, 32); }
            rs[ai][m] = rsqrtf(t * invK + EPS);
        }
}
struct EpiNull {
    float* sink;
    DI void operator()(const AccT& acc, const Unit& u, int wr, int wc, int fr, int fq) const {
        f32x4 t = acc[0][0][0][0];
#pragma unroll
        for (int ai = 0; ai < 2; ++ai)
#pragma unroll
            for (int bj = 0; bj < 2; ++bj)
#pragma unroll
                for (int m = 0; m < 4; ++m)
#pragma unroll
                    for (int n = 0; n < 2; ++n) t += acc[ai][bj][m][n];
        if (t.x == 12345.678f) sink[0] = t.y + t.z + t.w;
    }
};
struct EpiSwiglu {
    static constexpr bool PREFETCH = true;
    const float* ss; bf16_t* hid;
    DI void pre(const Unit& u, int wr, int wc, int fr, int fq, float (&rs)[2][4]) const { rstd8<16, 0, 4>(ss, (size_t)u.pm * 256 + wr * 64 + fr, 1.f / 1024.f, fq, rs); park(rs, (wr * 4 + wc) * 64 + fq * 16 + fr); }
    DI static LAS f32x4* slot(int t) { extern __shared__ __attribute__((aligned(16))) unsigned char lds_raw_[]; return (LAS f32x4*)((LAS unsigned char*)lds_raw_ + LDS_RS) + 2 * t; }
    DI static void park(const float (&rs)[2][4], int t) { LAS f32x4* p = slot(t); p[0] = (f32x4){rs[0][0], rs[0][1], rs[0][2], rs[0][3]}; p[1] = (f32x4){rs[1][0], rs[1][1], rs[1][2], rs[1][3]}; }
    DI static void unpark(float (&rs)[2][4], int t) { const LAS f32x4* p = slot(t); const f32x4 a = p[0], b = p[1]; rs[0][0] = a.x; rs[0][1] = a.y; rs[0][2] = a.z; rs[0][3] = a.w; rs[1][0] = b.x; rs[1][1] = b.y; rs[1][2] = b.z; rs[1][3] = b.w; }
    DI void operator()(const AccT& acc, const Unit& u, const Unit& nxt, bool has_next, int wr, int wc, int fr, int fq, float (&rs_unused)[2][4]) const {
        const size_t row0 = (size_t)u.pm * 256 + wr * 64 + fr;
        const int myt = (wr * 4 + wc) * 64 + fq * 16 + fr;
        float rs[2][4]; unpark(rs, myt);
        f32x4 nv[2][4];
        if (has_next) {
            const size_t nrow0 = (size_t)nxt.pm * 256 + wr * 64 + fr;
#pragma unroll
            for (int ai = 0; ai < 2; ++ai)
#pragma unroll
                for (int m = 0; m < 4; ++m) nv[ai][m] = *(const f32x4*)(ss + (nrow0 + ai * 128 + m * 16) * 16 + 4 * fq);
        }
#pragma unroll
        for (int ai = 0; ai < 2; ++ai)
#pragma unroll
            for (int m = 0; m < 4; ++m) {
                EPI_SCHED(); const size_t row = row0 + ai * 128 + m * 16;
                f32x4 o[2];
                const float c1 = -LOG2E * rs[ai][m], rs2 = rs[ai][m] * rs[ai][m];
#pragma unroll
                for (int n = 0; n < 2; ++n) {
                    const f32x4 gt = acc[ai][0][m][n], t = gt * acc[ai][1][m][n];
#pragma unroll
                    for (int e = 0; e < 4; ++e) o[n][e] = t[e] * (rs2 * frcp(1.f + fexp2(gt[e] * c1)));
                }
                *(u32x4*)(hid + row * FF + u.pn * 128 + wc * 32 + fq * 8) = pk8(o[0], o[1]);
            }
        if (has_next) {
#pragma unroll
            for (int ai = 0; ai < 2; ++ai)
#pragma unroll
                for (int m = 0; m < 4; ++m) {
                    float t = (nv[ai][m].x + nv[ai][m].y) + (nv[ai][m].z + nv[ai][m].w);
                    t += __shfl_xor(t, 16); t += __shfl_xor(t, 32);
                    rs[ai][m] = rsqrtf(t * (1.f / 1024.f) + EPS);
                }
            park(rs, myt);
        }
    }
};
struct EpiResid {
    bf16_t* hb; float* ss; float alpha;
    DI void operator()(const AccT& acc, const Unit& u, int wr, int wc, int fr, int fq) const {
        const size_t row0 = (size_t)u.pm * 256 + wr * 64 + fr;
        const int col0 = u.pn * 256 + wc * 32 + fq * 8;
#pragma unroll
        for (int ai = 0; ai < 2; ++ai) {
            EPI_SCHED();
            u32x4 hv[4][2];
#pragma unroll
            for (int m = 0; m < 4; ++m)
#pragma unroll
                for (int bj = 0; bj < 2; ++bj) hv[m][bj] = *(const u32x4*)(hb + (row0 + ai * 128 + m * 16) * D + col0 + bj * 128);
#pragma unroll
            for (int m = 0; m < 4; ++m) {
                const size_t row = row0 + ai * 128 + m * 16;
                float sq = 0.f;
#pragma unroll
                for (int bj = 0; bj < 2; ++bj) {
                    const u32x4 w = hv[m][bj];
                    f32x4 a, b;
                    a.x = __uint_as_float(w.x << 16); a.y = __uint_as_float(w.x & 0xffff0000u); a.z = __uint_as_float(w.y << 16); a.w = __uint_as_float(w.y & 0xffff0000u);
                    b.x = __uint_as_float(w.z << 16); b.y = __uint_as_float(w.z & 0xffff0000u); b.z = __uint_as_float(w.w << 16); b.w = __uint_as_float(w.w & 0xffff0000u);
                    a += acc[ai][bj][m][0] * alpha; b += acc[ai][bj][m][1] * alpha;
                    sq += (a.x * a.x + a.y * a.y) + (a.z * a.z + a.w * a.w) + (b.x * b.x + b.y * b.y) + (b.z * b.z + b.w * b.w);
                    *(u32x4*)(hb + row * D + col0 + bj * 128) = pk8(a, b);
                }
                sq += __shfl_xor(sq, 16); sq += __shfl_xor(sq, 32);
                if (fq == 0) ss[row * 16 + u.pn * 4 + wc] = sq;
            }
        }
    }
};
DI void rope4(f32x4& v0, f32x4& v1, const f32x4 c, const f32x4 s) {
    f32x4 a = v0, b = v1;
    v0.x = a.x * c.x - a.y * s.x; v0.y = a.x * s.x + a.y * c.x;
    v0.z = a.z * c.y - a.w * s.y; v0.w = a.z * s.y + a.w * c.y;
    v1.x = b.x * c.z - b.y * s.z; v1.y = b.x * s.z + b.y * c.z;
    v1.z = b.z * c.w - b.w * s.w; v1.w = b.z * s.w + b.w * c.w;
}
struct EpiMlaIn {
    const float* ss; bf16_t* cqkv; float* ssq; const float* rope; bf16_t* kr;
    DI void operator()(const AccT& acc, const Unit& u, int wr, int wc, int fr, int fq) const {
        const size_t row0 = (size_t)u.pm * 256 + wr * 64 + fr;
        float rs[2][4]; rstd8<16, 0, 4>(ss, row0, 1.f / 1024.f, fq, rs);
        const bool do_rope = (u.pn == 2) && (wc == 0);
#pragma unroll
        for (int ai = 0; ai < 2; ++ai) {
            EPI_SCHED();
            f32x4 cs[4], sn[4];
            if (do_rope) {
#pragma unroll
                for (int m = 0; m < 4; ++m) { const int s = (int)((row0 + ai * 128 + m * 16) & 2047); cs[m] = *(const f32x4*)(rope + s * 16 + 4 * fq); sn[m] = *(const f32x4*)(rope + 32768 + s * 16 + 4 * fq); }
            }
#pragma unroll
            for (int m = 0; m < 4; ++m) {
                const size_t row = row0 + ai * 128 + m * 16;
                float sq = 0.f;
#pragma unroll
                for (int bj = 0; bj < 2; ++bj) {
                    const int col = u.pn * 256 + bj * 128 + wc * 32 + fq * 8;
                    f32x4 a = acc[ai][bj][m][0] * rs[ai][m], b = acc[ai][bj][m][1] * rs[ai][m];
                    if (u.pn == 2 && bj == 1) {
                        if (wc == 0) { rope4(a, b, cs[m], sn[m]); *(u32x4*)(kr + row * 32 + fq * 8) = pk8(a, b); }
                    } else {
                        sq += (a.x * a.x + a.y * a.y) + (a.z * a.z + a.w * a.w) + (b.x * b.x + b.y * b.y) + (b.z * b.z + b.w * b.w);
                        *(u32x4*)(cqkv + row * 768 + col) = pk8(a, b);
                    }
                }
                sq += __shfl_xor(sq, 16); sq += __shfl_xor(sq, 32);
                if (fq == 0) ssq[row * 12 + u.pn * 4 + wc] = sq;
            }
        }
    }
};
struct EpiMlaQ {
    const float* ssq; bf16_t* q; const float* rope;
    DI void operator()(const AccT& acc, const Unit& u, int wr, int wc, int fr, int fq) const {
        const size_t row0 = (size_t)u.pm * 256 + wr * 64 + fr;
        float rs[2][4]; rstd8<12, 4, 2>(ssq, row0, 1.f / 384.f, fq, rs);
#pragma unroll
        for (int bj = 0; bj < 2; ++bj) {
            const int col = u.pn * 256 + bj * 128 + wc * 32 + fq * 8;
            const int d0 = col % 96; const bool do_rope = d0 >= 64; const int i0 = do_rope ? (d0 - 64) >> 1 : 0;
#pragma unroll
            for (int ai = 0; ai < 2; ++ai) {
                EPI_SCHED();
                f32x4 cs[4], sn[4];
                if (do_rope) {
#pragma unroll
                    for (int m = 0; m < 4; ++m) { const int s = (int)((row0 + ai * 128 + m * 16) & 2047); cs[m] = *(const f32x4*)(rope + s * 16 + i0); sn[m] = *(const f32x4*)(rope + 32768 + s * 16 + i0); }
                }
#pragma unroll
                for (int m = 0; m < 4; ++m) {
                    const size_t row = row0 + ai * 128 + m * 16;
                    f32x4 a = acc[ai][bj][m][0] * rs[ai][m], b = acc[ai][bj][m][1] * rs[ai][m];
                    if (do_rope) rope4(a, b, cs[m], sn[m]);
                    *(u32x4*)(q + row * 1536 + col) = pk8(a, b);
                }
            }
        }
    }
};
template <int STRIDE, int P0, int NP4>
struct EpiRowStore {
    const float* parts; float invK; bf16_t* out; int ldo;
    DI void operator()(const AccT& acc, const Unit& u, int wr, int wc, int fr, int fq) const {
        const size_t row0 = (size_t)u.pm * 256 + wr * 64 + fr;
        float rs[2][4]; rstd8<STRIDE, P0, NP4>(parts, row0, invK, fq, rs);
#pragma unroll
        for (int ai = 0; ai < 2; ++ai)
#pragma unroll
            for (int m = 0; m < 4; ++m) {
                EPI_SCHED(); const size_t row = row0 + ai * 128 + m * 16;
#pragma unroll
                for (int bj = 0; bj < 2; ++bj) {
                    const int col = u.pn * 256 + bj * 128 + wc * 32 + fq * 8;
                    const unsigned off = ((unsigned)(row >> 11) * 32768u + (unsigned)(row & 2047)) * 64u + (unsigned)(col >> 6) * 131072u + (unsigned)(col & 63);
                    *(u32x4*)(out + off) = pk8(acc[ai][bj][m][0] * rs[ai][m], acc[ai][bj][m][1] * rs[ai][m]);
                }
            }
    }
};
template <int STRIDE, int P0, int NP4>
struct EpiColScale {
    const float* parts; float invK; bf16_t* out; size_t nrows;
    DI void operator()(const AccT& acc, const Unit& u, int wr, int wc, int fr, int fq) const {
#pragma unroll
        for (int bj = 0; bj < 2; ++bj) {
            EPI_SCHED();
            const size_t col = (size_t)u.pn * 256 + bj * 128 + wc * 32 + fq * 8;
            f32x4 c0, c1;
            if (NP4 == 1) {
                f32x4 v[8];
#pragma unroll
                for (int e = 0; e < 8; ++e) v[e] = *(const f32x4*)(parts + (col + e) * STRIDE + P0);
#pragma unroll
                for (int e = 0; e < 4; ++e) { c0[e] = rsqrtf(((v[e].x + v[e].y) + (v[e].z + v[e].w)) * invK + EPS); c1[e] = rsqrtf(((v[4 + e].x + v[4 + e].y) + (v[4 + e].z + v[4 + e].w)) * invK + EPS); }
            } else {
#pragma unroll
                for (int hb2 = 0; hb2 < 2; ++hb2) {
                    f32x4 v[4][NP4];
#pragma unroll
                    for (int e = 0; e < 4; ++e)
#pragma unroll
                        for (int i = 0; i < NP4; ++i) v[e][i] = *(const f32x4*)(parts + (col + 4 * hb2 + e) * STRIDE + P0 + 4 * i);
#pragma unroll
                    for (int e = 0; e < 4; ++e) { float t = 0.f;
#pragma unroll
                        for (int i = 0; i < NP4; ++i) t += (v[e][i].x + v[e][i].y) + (v[e][i].z + v[e][i].w);
                        const float r = rsqrtf(t * invK + EPS); if (hb2 == 0) c0[e] = r; else c1[e] = r; }
                    EPI_SCHED();
                }
            }
#pragma unroll
            for (int ai = 0; ai < 2; ++ai)
#pragma unroll
                for (int m = 0; m < 4; ++m) {
                    const size_t row = (size_t)u.pm * 256 + ai * 128 + wr * 64 + m * 16 + fr;
                    *(u32x4*)(out + ((col >> 11) * nrows + row) * VPITCH + (col & 2047)) = pk8(acc[ai][bj][m][0] * c0, acc[ai][bj][m][1] * c1);
                }
        }
    }
};
struct EpiNsaIn {
    const float* ss; bf16_t* q; bf16_t* slab; float* gates;
    DI void operator()(const AccT& acc, const Unit& u, int wr, int wc, int fr, int fq) const {
        const size_t row0 = (size_t)u.pm * 256 + wr * 64 + fr;
        float rs[2][4]; rstd8<16, 0, 4>(ss, row0, 1.f / 1024.f, fq, rs);
#pragma unroll
        for (int ai = 0; ai < 2; ++ai)
#pragma unroll
            for (int m = 0; m < 4; ++m) {
                EPI_SCHED(); const size_t row = row0 + ai * 128 + m * 16;
                const size_t b = row >> 11, s = row & 2047;
#pragma unroll
                for (int bj = 0; bj < 2; ++bj) {
                    const int cc = bj * 128 + wc * 32 + fq * 8;
                    f32x4 a = acc[ai][bj][m][0] * rs[ai][m], c = acc[ai][bj][m][1] * rs[ai][m];
                    if (u.pn < 4) *(u32x4*)(q + row * 1024 + u.pn * 256 + cc) = pk8(a, c);
                    else if (u.pn < 8) { const int g = cc >> 6, d = cc & 63; *(u32x4*)(slab + (size_t)(u.pn - 4) * SLAB_EL + ((b * 4 + g) * 2048 + s) * 64 + d) = pk8(a, c); }
                    else if (cc < 48) {
#pragma unroll
                        for (int e = 0; e < 4; ++e) { a[e] = sigmoidf_(a[e]); c[e] = sigmoidf_(c[e]); }
                        *(f32x4*)(gates + row * 48 + cc) = a; *(f32x4*)(gates + row * 48 + cc + 4) = c;
                    }
                }
            }
    }
};

DI float wave_sum(float v) {
#pragma unroll
    for (int o = 1; o < 64; o <<= 1) v += __shfl_xor(v, o);
    return v;
}
#define LDS_FENCE() asm volatile("s_waitcnt lgkmcnt(0)" ::: "memory")
struct MapPlain { DI void operator()(int c, int& r, float& s) const { r = c; s = 1.f; } };
struct MapFfnGU { int half; DI void operator()(int c, int& r, float& s) const { r = (c >> 7) * 256 + half * 128 + (c & 127); s = 1.f; } };
struct MapMlaIn { DI void operator()(int c, int& r, float& s) const { s = 1.f;
    if (c < 384) r = 256 + c; else if (c < 640) r = c - 384; else { const int i = c - 640; r = 640 + (i < 16 ? 2 * i : 2 * (i - 16) + 1); } } };
struct MapMlaUq { DI void operator()(int c, int& r, float& s) const { s = 0.10206207261596577f * LOG2E;
    const int h = c / 96, d = c % 96; r = h * 96 + (d < 64 ? d : (d < 80 ? 64 + 2 * (d - 64) : 64 + 2 * (d - 80) + 1)); } };
struct MapMlaUkv { DI void operator()(int c, int& r, float& s) const { s = 1.f; const int h = c >> 7, d = c & 127; r = d < 64 ? h * 64 + d : 1024 + h * 64 + (d - 64); } };
struct MapNsaIn { DI void operator()(int c, int& r, float& s) const { s = 1.f;
    if (c < 1024) { r = c; s = 0.125f * LOG2E; }
    else if (c < 1792) r = c;
    else if (c < 2048) r = 2304 + (c - 1792);
    else if (c < 2304) r = 1792 + (c - 2048);
    else if (c < 2560) r = 2560 + (c - 2304);
    else r = 2048 + (c - 2560); } };
template <class Map>
DI void p0_transpose(const float* W, int K, int N, bf16_t* WT, const float* gain, const Map map, LAS float* scr, int& base, int gw, int NGW, int lane) {
    const int nblk = (N + 31) / 32, nitems = (K / 64) * nblk;
    int first = gw - (base % NGW); if (first < 0) first += NGW;
    base += nitems;
    float cur[32], nxt[32];
    auto loadit = [&](int it, float (&dst)[32]) {
        const int kb = it / nblk, nb = it % nblk, k0 = 64 * kb, c = 32 * nb + (lane & 31);
        const float* p = W + (size_t)(k0 + (lane >> 5)) * N + c;
#pragma unroll
        for (int i = 0; i < 32; ++i) dst[i] = (c < N) ? p[(size_t)(2 * i) * N] : 0.f;
    };
    if (first < nitems) loadit(first, cur);
    for (int it = first; it < nitems; it += NGW) {
        const bool more = it + NGW < nitems;
        if (more) loadit(it + NGW, nxt);
        const int kb = it / nblk, nb = it % nblk, k0 = 64 * kb, n0 = 32 * nb;
#pragma unroll
        for (int i = 0; i < 32; ++i) { const int kk = 2 * i + (lane >> 5); float v = cur[i]; if (gain) v *= gain[k0 + kk]; scr[kk * 33 + (lane & 31)] = v; }
        LDS_FENCE();
        const int ch = lane & 7;
#pragma unroll
        for (int j = 0; j < 4; ++j) { const int n = (lane >> 3) + 8 * j; const int cc = n0 + n;
            if (cc < N) { int r; float sc; map(cc, r, sc); const LAS float* s = scr + (8 * ch) * 33 + n;
                u32x4 o; o.x = pk2(s[0] * sc, s[33] * sc); o.y = pk2(s[66] * sc, s[99] * sc); o.z = pk2(s[132] * sc, s[165] * sc); o.w = pk2(s[198] * sc, s[231] * sc);
                *(u32x4*)(WT + (size_t)r * K + k0 + 8 * ch) = o; } }
        LDS_FENCE();
        if (more) {
#pragma unroll
            for (int i = 0; i < 32; ++i) cur[i] = nxt[i];
        }
    }
}

struct Params {
    const float* in[26];
    float* out;
    unsigned char* ws;
    int ph_lo, ph_hi;
};

DI void p0_prologue(int wv, const Params& P, LAS unsigned char* lds) {
    const int tid = opaque_tid(wv), lane = tid & 63, wave = __builtin_amdgcn_readfirstlane(tid >> 6);
    const int G = gridDim.x, gw = blockIdx.x * 8 + wave, NGW = G * 8;
    LAS float* scr = (LAS float*)(lds + wave * 8448);
    bf16_t* Wb = (bf16_t*)(P.ws + WS_W);
    int base = 0;
    for (int L = 0; L < 4; ++L)
        for (int ab = 0; ab < 2; ++ab) {
            bf16_t* wf = Wb + (size_t)(L * 2 + ab) * FFN_SZ;
            const float* nrm = P.in[ab ? 6 : 1] + L * D;
            const float* wg = P.in[ab ? 7 : 2] + (size_t)L * D * FF; const float* wu = P.in[ab ? 8 : 3] + (size_t)L * D * FF; const float* wd = P.in[ab ? 9 : 4] + (size_t)L * FF * D;
            p0_transpose(wg, D, FF, wf + FFN_WGU, nrm, MapFfnGU{0}, scr, base, gw, NGW, lane);
            p0_transpose(wu, D, FF, wf + FFN_WGU, nrm, MapFfnGU{1}, scr, base, gw, NGW, lane);
            p0_transpose(wd, FF, D, wf + FFN_WD, nullptr, MapPlain{}, scr, base, gw, NGW, lane);
        }
    for (int j = 0; j < 2; ++j) {
        bf16_t* wm = Wb + W_MLA + (size_t)j * MLA_SZ;
        const float* mixn = P.in[5] + (2 * j) * D;
        p0_transpose(P.in[12] + (size_t)j * 1024 * 672, 1024, 672, wm + MLA_WIN, mixn, MapMlaIn{}, scr, base, gw, NGW, lane);
        p0_transpose(P.in[15] + (size_t)j * 384 * 1536, 384, 1536, wm + MLA_WUQ, P.in[13] + j * 384, MapMlaUq{}, scr, base, gw, NGW, lane);
        p0_transpose(P.in[16] + (size_t)j * 256 * 2048, 256, 2048, wm + MLA_WUKV, P.in[14] + j * 256, MapMlaUkv{}, scr, base, gw, NGW, lane);
        p0_transpose(P.in[17] + (size_t)j * 1024 * 1024, 1024, 1024, wm + MLA_WO, nullptr, MapPlain{}, scr, base, gw, NGW, lane);
        bf16_t* wn = Wb + W_NSA + (size_t)j * NSA_SZ;
        const float* mixn2 = P.in[5] + (2 * j + 1) * D;
        p0_transpose(P.in[18] + (size_t)j * 1024 * 2608, 1024, 2608, wn + NSA_WIN, mixn2, MapNsaIn{}, scr, base, gw, NGW, lane);
        p0_transpose(P.in[20] + (size_t)j * 2048 * 128, 2048, 128, wn + NSA_W1K, nullptr, MapPlain{}, scr, base, gw, NGW, lane);
        p0_transpose(P.in[23] + (size_t)j * 2048 * 128, 2048, 128, wn + NSA_W1V, nullptr, MapPlain{}, scr, base, gw, NGW, lane);
        p0_transpose(P.in[21] + (size_t)j * 128 * 64, 128, 64, wn + NSA_W2K, nullptr, MapPlain{}, scr, base, gw, NGW, lane);
        p0_transpose(P.in[24] + (size_t)j * 128 * 64, 128, 64, wn + NSA_W2V, nullptr, MapPlain{}, scr, base, gw, NGW, lane);
        p0_transpose(P.in[25] + (size_t)j * 1024 * 1024, 1024, 1024, wn + NSA_WO, nullptr, MapPlain{}, scr, base, gw, NGW, lane);
    }
    {
        float* rope = (float*)(P.ws + WS_ROPE);
        for (int idx = blockIdx.x * 512 + tid; idx < 32768; idx += G * 512) {
            const int pos = idx >> 4, i = idx & 15;
            const float inv = powf(10000.0f, -(float)i * (2.0f / 32.0f));
            const float ang = (float)pos * inv;
            rope[idx] = cosf(ang); rope[32768 + idx] = sinf(ang);
        }
    }
    {
        float* c1 = (float*)(P.ws + WS_C1);
        for (int o = gw; o < 512; o += NGW) {
            const int j = o >> 8, kv = (o >> 7) & 1, col = o & 127;
            const float* pos = P.in[kv ? 22 : 19] + (size_t)j * 2048; const float* w1 = P.in[kv ? 23 : 20] + (size_t)j * 2048 * 128;
            float s = 0.f;
            for (int i = lane; i < 2048; i += 64) s += pos[i] * w1[(size_t)i * 128 + col];
            s = wave_sum(s);
            if (lane == 0) c1[o] = s;
        }
    }
    {
        const float* x = P.in[0]; bf16_t* hb = (bf16_t*)(P.ws + WS_HB); float* ss = (float*)(P.ws + WS_SS);
        for (int m = gw; m < M; m += 2 * NGW) {
            f32x4 v[2][4];
#pragma unroll
            for (int e = 0; e < 2; ++e)
#pragma unroll
                for (int j = 0; j < 4; ++j) v[e][j] = ((const f32x4*)(x + (size_t)((m + e * NGW) < M ? (m + e * NGW) : m) * D) + lane)[64 * j];
#pragma unroll
            for (int e = 0; e < 2; ++e) {
                if (m + e * NGW >= M) break;
                const size_t mm = (size_t)(m + e * NGW);
                unsigned long long* o8 = (unsigned long long*)(hb + mm * D) + lane;
                float s = 0.f;
#pragma unroll
                for (int j = 0; j < 4; ++j) { const f32x4 t = v[e][j]; s += (t.x * t.x + t.y * t.y) + (t.z * t.z + t.w * t.w);
                    o8[64 * j] = (unsigned long long)pk2(t.x, t.y) | ((unsigned long long)pk2(t.z, t.w) << 32); }
                s = wave_sum(s);
                if (lane < 16) ss[mm * 16 + lane] = (lane == 0) ? s : 0.f;
            }
        }
    }
}

DI void final_norm_phase(int wv, const Params& P) {
    const int tid = opaque_tid(wv), lane = tid & 63, wave = tid >> 6;
    const int gw = blockIdx.x * 8 + wave, NGW = gridDim.x * 8;
    const float* gn = P.in[10]; const bf16_t* hb = (const bf16_t*)(P.ws + WS_HB);
    f32x4 gv[4];
#pragma unroll
    for (int j = 0; j < 4; ++j) gv[j] = ((const f32x4*)gn)[lane + 64 * j];
    for (int m = gw; m < M; m += NGW) {
        const u32x2* hr = (const u32x2*)(hb + (size_t)m * D) + lane; f32x4* orow = (f32x4*)(P.out + (size_t)m * D) + lane;
        f32x4 v[4]; float s = 0.f;
#pragma unroll
        for (int j = 0; j < 4; ++j) { const u32x2 w = hr[64 * j];
            v[j].x = __uint_as_float(w.x << 16); v[j].y = __uint_as_float(w.x & 0xffff0000u); v[j].z = __uint_as_float(w.y << 16); v[j].w = __uint_as_float(w.y & 0xffff0000u);
            s += (v[j].x * v[j].x + v[j].y * v[j].y) + (v[j].z * v[j].z + v[j].w * v[j].w); }
        const float rs = rsqrtf(wave_sum(s) * (1.f / 1024.f) + EPS);
#pragma unroll
        for (int j = 0; j < 4; ++j) orow[64 * j] = v[j] * rs * gv[j];
    }
}

DI f32x16 mfma32(bf16x8 a, bf16x8 b, f32x16 c) { return __builtin_amdgcn_mfma_f32_32x32x16_bf16(a, b, c, 0, 0, 0); }
DI int crow(int i, int hh) { return (i & 3) + 8 * (i >> 2) + 4 * hh; }
DI f32x16 zero16() { f32x16 z; for (int i = 0; i < 16; ++i) z[i] = 0.f; return z; }
template <int S_>
DI bf16x8 pack8(const f32x16& x) {
    u32x4 p; p.x = pk2(x[8 * S_], x[8 * S_ + 1]); p.y = pk2(x[8 * S_ + 2], x[8 * S_ + 3]); p.z = pk2(x[8 * S_ + 4], x[8 * S_ + 5]); p.w = pk2(x[8 * S_ + 6], x[8 * S_ + 7]);
    return __builtin_bit_cast(bf16x8, p);
}
DI f32x16 splat16(float v) { f32x16 z; for (int i = 0; i < 16; ++i) z[i] = v; return z; }
DI bf16x8 ref_frag(float negm, float extra, int hh) {
    const unsigned hi = pk2(negm, 0.f) & 0xffffu;
    const unsigned lo = pk2(negm - __uint_as_float(hi << 16), 0.f) & 0xffffu;
    const unsigned ex = pk2(extra, 0.f) & 0xffffu;
    u32x4 v; v.x = hh ? 0u : (hi | (lo << 16)); v.y = hh ? 0u : ex; v.z = 0u; v.w = 0u;
    return __builtin_bit_cast(bf16x8, v);
}
DI bf16x8 ones_frag(int hh) { u32x4 v; v.x = hh ? 0u : 0x3F803F80u; v.y = hh ? 0u : 0x00003F80u; v.z = 0u; v.w = 0u; return __builtin_bit_cast(bf16x8, v); }
template <int NKS>
DI void qk_tile(const LAS unsigned char* kt, int kstride, const bf16x8 (&qf)[NKS], f32x16 (&s)[2], int r, int hh, const bf16x8 rf) {
    const bf16x8 of = ones_frag(hh);
#pragma unroll
    for (int t = 0; t < 2; ++t) {
        bf16x8 kf[NKS];
#pragma unroll
        for (int ks = 0; ks < NKS; ++ks) kf[ks] = *(const LAS bf16x8*)(kt + (32 * t + r) * kstride + 32 * ks + 16 * hh);
        __builtin_amdgcn_sched_barrier(0);
        s[t] = zero16();
#pragma unroll
        for (int ks = 0; ks < NKS; ++ks) s[t] = mfma32(kf[ks], qf[ks], s[t]);
        s[t] = mfma32(of, rf, s[t]);
        __builtin_amdgcn_sched_barrier(0);
    }
}
DI void pv_sub(const LAS unsigned char* vt, int vstride, int koff_bytes, const f32x16& p, f32x16 (&o)[2], int r, int hh) {
    const bf16x8 pf0 = pack8<0>(p), pf1 = pack8<1>(p);
#pragma unroll
    for (int st = 0; st < 2; ++st) {
        u32x2 lo[2], hi[2];
#pragma unroll
        for (int u = 0; u < 2; ++u) {
            const LAS unsigned char* a = vt + (32 * u + r) * vstride + koff_bytes + 32 * st + 8 * hh;
            lo[u] = *(const LAS u32x2*)a; hi[u] = *(const LAS u32x2*)(a + 16);
        }
        __builtin_amdgcn_sched_barrier(0);
#pragma unroll
        for (int u = 0; u < 2; ++u) { u32x4 v; v.x = lo[u].x; v.y = lo[u].y; v.z = hi[u].x; v.w = hi[u].y; o[u] = mfma32(__builtin_bit_cast(bf16x8, v), st ? pf1 : pf0, o[u]); }
    }
}
DI void softmax_lazy(f32x16 (&s)[2], float& m, float& l, f32x16 (&o)[2], int hh) {
    float mx = s[0][0];
#pragma unroll
    for (int i = 1; i < 16; ++i) mx = fmaxf(mx, s[0][i]);
#pragma unroll
    for (int i = 0; i < 16; ++i) mx = fmaxf(mx, s[1][i]);
    mx = fmaxf(mx, __shfl_xor(mx, 32));
    const bool live = mx > -1e29f;
    const bool slow = live && (mx > 32.f || (mx < -32.f && l == 0.f));
    if (__ballot(slow) != 0ull) {
        const float shift = (live && (mx > 0.f || l == 0.f)) ? mx : 0.f;
        const float alpha = (l == 0.f) ? 0.f : fexp2(-shift);
        const bf16x8 of = ones_frag(hh), sf = ref_frag(-shift, 0.f, hh);
        s[0] = mfma32(of, sf, s[0]); s[1] = mfma32(of, sf, s[1]);
        l *= alpha; m += shift;
        o[0] *= alpha; o[1] *= alpha;
    }
    float sum = 0.f;
#pragma unroll
    for (int t = 0; t < 2; ++t)
#pragma unroll
        for (int i = 0; i < 16; ++i) { s[t][i] = fexp2(s[t][i]); sum += s[t][i]; }
    sum += __shfl_xor(sum, 32);
    l += sum;
}
DI void softmax_lazy1(f32x16& s, float& m, float& l, f32x16 (&o)[2], int hh) {
    float mx = s[0];
#pragma unroll
    for (int i = 1; i < 16; ++i) mx = fmaxf(mx, s[i]);
    mx = fmaxf(mx, __shfl_xor(mx, 32));
    const bool live = mx > -1e29f;
    const bool slow = live && (mx > 32.f || (mx < -32.f && l == 0.f));
    if (__ballot(slow) != 0ull) {
        const float shift = (live && (mx > 0.f || l == 0.f)) ? mx : 0.f;
        const float alpha = (l == 0.f) ? 0.f : fexp2(-shift);
        s = mfma32(ones_frag(hh), ref_frag(-shift, 0.f, hh), s);
        l *= alpha; m += shift;
        o[0] *= alpha; o[1] *= alpha;
    }
    float sum = 0.f;
#pragma unroll
    for (int i = 0; i < 16; ++i) { s[i] = fexp2(s[i]); sum += s[i]; }
    sum += __shfl_xor(sum, 32);
    l += sum;
}
DI void lds_store16_as2x8(LAS unsigned char* p, u32x4 v) { u32x2 a, b; a.x = v.x; a.y = v.y; b.x = v.z; b.y = v.w; *(LAS u32x2*)p = a; *(LAS u32x2*)(p + 8) = b; }
DI void store_ot(const f32x16 (&o)[2], float sc, bf16_t* dst  , int hh) {
#pragma unroll
    for (int u = 0; u < 2; ++u)
#pragma unroll
        for (int gq = 0; gq < 4; ++gq) {
            u32x2 w; w.x = pk2(o[u][4 * gq] * sc, o[u][4 * gq + 1] * sc); w.y = pk2(o[u][4 * gq + 2] * sc, o[u][4 * gq + 3] * sc);
            *(u32x2*)(dst + 32 * u + 8 * gq + 4 * hh) = w;
        }
}

DI void pv_sub2(const LAS unsigned char* vt, int vstride, int koff_bytes, const f32x16& p0, const f32x16& p1, f32x16 (&o0)[2], f32x16 (&o1)[2], int r, int hh) {
#pragma unroll
    for (int st = 0; st < 2; ++st) {
        u32x2 lo[2], hi[2];
#pragma unroll
        for (int u = 0; u < 2; ++u) {
            const LAS unsigned char* a = vt + (32 * u + r) * vstride + koff_bytes + 32 * st + 8 * hh;
            lo[u] = *(const LAS u32x2*)a; hi[u] = *(const LAS u32x2*)(a + 16);
        }
        const bf16x8 pf0 = st ? pack8<1>(p0) : pack8<0>(p0), pf1 = st ? pack8<1>(p1) : pack8<0>(p1);
        __builtin_amdgcn_sched_barrier(0);
#pragma unroll
        for (int u = 0; u < 2; ++u) { u32x4 v; v.x = lo[u].x; v.y = lo[u].y; v.z = hi[u].x; v.w = hi[u].y; const bf16x8 vf = __builtin_bit_cast(bf16x8, v);
            o0[u] = mfma32(vf, pf0, o0[u]); o1[u] = mfma32(vf, pf1, o1[u]); }
    }
}
struct VFrag8 { u32x2 lo[2][2], hi[2][2]; };
DI void pv_load2(const LAS unsigned char* vt, int vstride, int koff_bytes, VFrag8& f, int r, int hh) {
#pragma unroll
    for (int st = 0; st < 2; ++st)
#pragma unroll
        for (int u = 0; u < 2; ++u) {
            const LAS unsigned char* a = vt + (32 * u + r) * vstride + koff_bytes + 32 * st + 8 * hh;
            f.lo[st][u] = *(const LAS u32x2*)a; f.hi[st][u] = *(const LAS u32x2*)(a + 16);
        }
}
DI void pv_mma2(const VFrag8& f, const f32x16& p0, const f32x16& p1, f32x16 (&o0)[2], f32x16 (&o1)[2]) {
#pragma unroll
    for (int st = 0; st < 2; ++st) {
        const bf16x8 pf0 = st ? pack8<1>(p0) : pack8<0>(p0), pf1 = st ? pack8<1>(p1) : pack8<0>(p1);
#pragma unroll
        for (int u = 0; u < 2; ++u) { u32x4 v; v.x = f.lo[st][u].x; v.y = f.lo[st][u].y; v.z = f.hi[st][u].x; v.w = f.hi[st][u].y; const bf16x8 vf = __builtin_bit_cast(bf16x8, v);
            o0[u] = mfma32(vf, pf0, o0[u]); o1[u] = mfma32(vf, pf1, o1[u]); }
    }
}
template <int NKS>
DI void qk_tile2(const LAS unsigned char* kt, int kstride, const bf16x8 (&q0)[NKS], const bf16x8 (&q1)[NKS], f32x16 (&s0)[2], f32x16 (&s1)[2], int r, int hh) {
#pragma unroll
    for (int t = 0; t < 2; ++t) {
        s0[t] = zero16(); s1[t] = zero16();
#pragma unroll
        for (int ks = 0; ks < NKS; ++ks) {
            const bf16x8 kf = *(const LAS bf16x8*)(kt + (32 * t + r) * kstride + 32 * ks + 16 * hh);
            s0[t] = mfma32(kf, q0[ks], s0[t]); s1[t] = mfma32(kf, q1[ks], s1[t]);
        }
    }
}
DI void mla_qblock(int wv, int w, LAS unsigned char* lds, const bf16_t* Q, const bf16_t* KN, const bf16_t* KR, const bf16_t* VT, bf16_t* O, size_t tok0, int h, int qb) {
    constexpr int KS = 208, VS = 136, VOFF = 64 * KS, TILE = VOFF + 64 * VS;
    const int tid = opaque_tid(wv), lane = tid & 63, r = lane & 31, hh = lane >> 5;
    const int R0 = 512 * qb + 64 * w, tq0 = R0 + r, tq1 = tq0 + 32;
    bf16x8 q0[6], q1[6];
#pragma unroll
    for (int ks = 0; ks < 6; ++ks) { q0[ks] = *(const bf16x8*)(Q + (tok0 + tq0) * 1536 + h * 96 + 16 * ks + 8 * hh); q1[ks] = *(const bf16x8*)(Q + (tok0 + tq1) * 1536 + h * 96 + 16 * ks + 8 * hh); }
    float m0 = 0.f, l0 = 0.f, m1 = 0.f, l1 = 0.f; f32x16 o0[2] = {zero16(), zero16()}, o1[2] = {zero16(), zero16()};
    const int nt = 8 * qb + 8, nfull = 8 * qb;
    u32x4 rk, rr, rv;
    const bf16_t* gk = KN + ((tok0 >> 11) * 16 + h) * (size_t)(2048 * 64) + (size_t)tid * 8;
    const bf16_t* gr = KR + tok0 * 32 + (size_t)tid * 8;
    const bf16_t* gv = VT + ((tok0 >> 11) * 1024 + h * 64 + (tid >> 3)) * (size_t)VPITCH + (tid & 7) * 8;
    const bool lo256 = tid < 256;
#define MLA_GLOAD(t) do { const size_t ko = (size_t)(64 * (t)); rk = *(const u32x4*)(gk + ko * 64); if (lo256) rr = *(const u32x4*)(gr + ko * 32); rv = *(const u32x4*)(gv + ko); } while (0)
#define MLA_LSTORE(buf) do { LAS unsigned char* kb_ = lds + (buf) * TILE; *(LAS u32x4*)(kb_ + (tid >> 3) * KS + (tid & 7) * 16) = rk; \
        if (lo256) *(LAS u32x4*)(kb_ + (tid >> 2) * KS + 128 + (tid & 3) * 16) = rr; lds_store16_as2x8(kb_ + VOFF + (tid >> 3) * VS + (tid & 7) * 16, rv); } while (0)
    MLA_GLOAD(0); MLA_LSTORE(0); if (nt > 1) MLA_GLOAD(1); __syncthreads();
#define MLA_QK1(tt) do { bf16x8 kf_[6]; _Pragma("unroll") for (int ks = 0; ks < 6; ++ks) kf_[ks] = *(const LAS bf16x8*)(kb + (32 * (tt) + r) * KS + 32 * ks + 16 * hh); \
        __builtin_amdgcn_sched_barrier(0); s0 = zero16(); s1 = zero16(); \
        _Pragma("unroll") for (int ks = 0; ks < 6; ++ks) { s0 = mfma32(kf_[ks], q0[ks], s0); s1 = mfma32(kf_[ks], q1[ks], s1); } \
        { const bf16x8 of_ = ones_frag(hh); s0 = mfma32(of_, ref_frag(-m0, 0.f, hh), s0); s1 = mfma32(of_, ref_frag(-m1, 0.f, hh), s1); } } while (0)
    int bi = 0;
    for (int t = 0; t < nfull; ++t) {
        const int bn = bi == 2 ? 0 : bi + 1;
        MLA_LSTORE(bn);
        if (t + 2 < nt) MLA_GLOAD(t + 2);
        const LAS unsigned char* kb = lds + bi * TILE;
#pragma nounroll
        for (int tt = 0; tt < 2; ++tt) {
            f32x16 s0, s1;
            MLA_QK1(tt);
            VFrag8 vf8; pv_load2(kb + VOFF, VS, 64 * tt, vf8, r, hh);
            __builtin_amdgcn_sched_barrier(0);
            softmax_lazy1(s0, m0, l0, o0, hh); softmax_lazy1(s1, m1, l1, o1, hh);
            pv_mma2(vf8, s0, s1, o0, o1);
        }
        __syncthreads();
        bi = bn;
    }
#pragma nounroll
    for (int t = nfull; t < nt; ++t) {
        const int bn = bi == 2 ? 0 : bi + 1;
        if (t + 1 < nt) MLA_LSTORE(bn);
        if (t + 2 < nt) MLA_GLOAD(t + 2);
        const int k0 = 64 * t;
        if (k0 <= R0 + 63) {
            const LAS unsigned char* kb = lds + bi * TILE;
#pragma nounroll
            for (int tt = 0; tt < 2; ++tt) {
                f32x16 s0, s1;
                MLA_QK1(tt);
#pragma unroll
                for (int i = 0; i < 16; ++i) { const int key = k0 + 32 * tt + crow(i, hh); if (key > tq0) s0[i] = NEGF; if (key > tq1) s1[i] = NEGF; }
                softmax_lazy1(s0, m0, l0, o0, hh); softmax_lazy1(s1, m1, l1, o1, hh);
                pv_sub2(kb + VOFF, VS, 64 * tt, s0, s1, o0, o1, r, hh);
            }
        }
        __syncthreads();
        bi = bn;
    }
#undef MLA_QK1
    store_ot(o0, frcp(l0), O + (tok0 + tq0) * 1024 + h * 64, hh);
    store_ot(o1, frcp(l1), O + (tok0 + tq1) * 1024 + h * 64, hh);
#undef MLA_GLOAD
#undef MLA_LSTORE
}
template <int SKIP>
DI void mla_attn_phase(int wv, LAS unsigned char* lds, const bf16_t* Q, const bf16_t* KN, const bf16_t* KR, const bf16_t* VT, bf16_t* O) {
    const int w = __builtin_amdgcn_readfirstlane(opaque_tid(wv) >> 6);
    const int bx = blockIdx.x, nG = gridDim.x;
    const int vcu = (nG == 256) ? (bx & 7) * 32 + (bx >> 3) : bx;
    for (int grp = vcu >> 2; grp < 64; grp += (nG + 3) >> 2) {
        const int k = vcu & 3;
#pragma nounroll
        for (int it = 0; it < 4; ++it) {
            const int pair = grp * 4 + it, qb = (it & 1) ? 3 - k : k;
            mla_qblock(wv, w, lds, Q, KN, KR, VT, O, (size_t)(pair >> 4) * SEQ, pair & 15, qb);
        }
    }
}

DI void nsa_compress_phase(int wv, LAS unsigned char* lds, const bf16_t* slab  , const bf16_t* wn  , const float* c1  , bf16_t* KCMP, bf16_t* VCMPT) {
    constexpr int HS = 272;
    const int tid = opaque_tid(wv), lane = tid & 63, w = __builtin_amdgcn_readfirstlane(tid >> 6), r = lane & 31, hh = lane >> 5;
    for (int item = blockIdx.x; item < 256; item += gridDim.x) {
        const int b = item >> 4, g = (item >> 2) & 3, kv = (item >> 1) & 1, nh = item & 1;
        const bf16_t* src = slab + (size_t)kv * SLAB_EL + (size_t)(b * 4 + g) * 2048 * 64;
        const bf16_t* w1t = wn + (kv ? NSA_W1V : NSA_W1K); const bf16_t* w2t = wn + (kv ? NSA_W2V : NSA_W2K);
        {
            const int rh = w >> 2, cq = w & 3;
            int n = 64 * nh + 32 * rh + r; if (n > 126) n = 126;
            const bf16_t* ap = src + (size_t)n * 1024 + 8 * hh;
            const bf16_t* bp = w1t + (size_t)(32 * cq + r) * 2048 + 8 * hh;
            f32x16 acc = zero16();
#pragma unroll 8
            for (int ks = 0; ks < 128; ++ks) {
                const bf16x8 xa = *(const bf16x8*)(ap + 16 * ks), wb = *(const bf16x8*)(bp + 16 * ks);
                acc = mfma32(wb, xa, acc);
            }
            const float* cb = c1 + kv * 128;
#pragma unroll
            for (int gq = 0; gq < 4; ++gq) {
                float v[4];
#pragma unroll
                for (int e = 0; e < 4; ++e) { const int j = 32 * cq + 8 * gq + 4 * hh + e; const float x = acc[4 * gq + e] + cb[j];
                    const float u2 = 2.f * 0.7978845608028654f * (x + 0.044715f * x * x * x); v[e] = x * sigmoidf_(u2); }
                u32x2 wv; wv.x = pk2(v[0], v[1]); wv.y = pk2(v[2], v[3]);
                *(LAS u32x2*)(lds + (32 * rh + r) * HS + (32 * cq + 8 * gq + 4 * hh) * 2) = wv;
            }
        }
        __syncthreads();
        if (w < 4) {
            const int rh2 = w >> 1, dq = w & 1;
            f32x16 acc = zero16();
#pragma unroll
            for (int ks = 0; ks < 8; ++ks) {
                const bf16x8 hf = *(const LAS bf16x8*)(lds + (32 * rh2 + r) * HS + (16 * ks + 8 * hh) * 2);
                const bf16x8 wf = *(const bf16x8*)(w2t + (size_t)(32 * dq + r) * 128 + 16 * ks + 8 * hh);
                if (kv == 0) acc = mfma32(wf, hf, acc);
                else acc = mfma32(hf, wf, acc);
            }
            if (kv == 0) {
                bf16_t* dst = KCMP + ((size_t)(b * 4 + g) * 128 + 64 * nh + 32 * rh2 + r) * 64 + 32 * dq;
#pragma unroll
                for (int gq = 0; gq < 4; ++gq) { u32x2 wv; wv.x = pk2(acc[4 * gq], acc[4 * gq + 1]); wv.y = pk2(acc[4 * gq + 2], acc[4 * gq + 3]); *(u32x2*)(dst + 8 * gq + 4 * hh) = wv; }
            } else {
                bf16_t* dst = VCMPT + ((size_t)(b * 4 + g) * 64 + 32 * dq + r) * 128 + 64 * nh + 32 * rh2;
#pragma unroll
                for (int gq = 0; gq < 4; ++gq) { u32x2 wv; wv.x = pk2(acc[4 * gq], acc[4 * gq + 1]); wv.y = pk2(acc[4 * gq + 2], acc[4 * gq + 3]); *(u32x2*)(dst + 8 * gq + 4 * hh) = wv; }
            }
        }
        __syncthreads();
    }
}

DI int t5_bucket(int n) {
    if (n < 16) return n;
    int v = 16 + (int)(logf((float)n / 16.f) / 2.0794415416798357f * 16.f);
    return v < 31 ? v : 31;
}
DI void nsa_attn_phase(int wv, LAS unsigned char* lds, const bf16_t* Q, const bf16_t* slab, const bf16_t* VT2, const float* gates, const bf16_t* KCMP, const bf16_t* VCMPT,
                       const float* rel_bias, bf16_t* O) {
    constexpr int KCS = 144, VCS = 264, KS = 144, VS = 136;
    constexpr int OFF_KC = 0, OFF_VC = 128 * KCS, OFF_BUF = OFF_VC + 64 * VCS, VOFF = 64 * KS, TILE = VOFF + 64 * VS, BUF = 2 * TILE;
    constexpr int OFF_IMP = OFF_BUF  , OFF_SC = OFF_IMP + 4 * 64 * 33 * 4;
    constexpr int OFF_SEL = OFF_BUF + 2 * BUF, OFF_LUT = OFF_SEL + 256;
    static_assert(OFF_SC + 64 * 33 * 4 <= OFF_SEL && OFF_LUT + 2048 <= LDS_GEMM, "nsa lds");
    const int tid0 = opaque_tid(wv), w = __builtin_amdgcn_readfirstlane(tid0 >> 6);
    const int rhead = w & 3, half = w >> 2;
    LAS float* impw = (LAS float*)(lds + OFF_IMP); LAS float* score = (LAS float*)(lds + OFF_SC); LAS unsigned* selm = (LAS unsigned*)(lds + OFF_SEL); LAS float* lut = (LAS float*)(lds + OFF_LUT);
#if PROBE_VARIANT == 3 || PROBE_VARIANT == 4
#pragma nounroll
    for (int nrep = 0; nrep < 2; ++nrep)
#else
    constexpr int nrep = 1;
#endif
    for (int item0 = blockIdx.x; item0 < 256; item0 += gridDim.x) {
        const int item = (gridDim.x == 256) ? (item0 & 7) * 32 + (item0 >> 3) : item0;
        const int b = item >> 4, g = (item >> 2) & 3, qtr = item & 3;
        const int head = g * 4 + rhead;
        const size_t bg = (size_t)(b * 4 + g);
        int tid = opaque_tid(wv), lane = tid & 63;
        __syncthreads();
#pragma unroll
        for (int e = 0; e < 2; ++e) { const int pc = tid + 512 * e;
            const u32x4 v = *(const u32x4*)(KCMP + bg * 128 * 64 + (size_t)pc * 8); *(LAS u32x4*)(lds + OFF_KC + (pc >> 3) * KCS + (pc & 7) * 16) = v;
            const u32x4 v2 = *(const u32x4*)(VCMPT + bg * 64 * 128 + (size_t)pc * 8); lds_store16_as2x8(lds + OFF_VC + (pc >> 4) * VCS + (pc & 15) * 16, v2); }
        lut[tid] = rel_bias[t5_bucket(tid & 127) * 16 + g * 4 + (tid >> 7)] * LOG2E;
        __syncthreads();
        const LAS float* mylut = lut + rhead * 128;
#pragma nounroll
        for (int qi = 0; qi < 8; ++qi) {
            tid = opaque_tid(wv); lane = tid & 63; const int r = lane & 31, hh = lane >> 5;
            const int qblk = 4 * qi + ((qi & 1) ? 3 - qtr : qtr), T0 = 64 * qblk, TW = T0 + 32 * half;
            const int tq = TW + r; const size_t token = (size_t)b * SEQ + tq;
            const float c31 = mylut[127];
            bf16x8 qf[4];
#pragma unroll
            for (int ks = 0; ks < 4; ++ks) qf[ks] = *(const bf16x8*)(Q + token * 1024 + head * 64 + 16 * ks + 8 * hh);
            const float g0 = gates[token * 48 + head * 3], g1 = gates[token * 48 + head * 3 + 1], g2 = gates[token * 48 + head * 3 + 2];
            f32x16 out[2] = {zero16(), zero16()};
            const bool need_rank = qblk >= 16;
            {
                const int nsub = (TW >> 9) + 1;
                f32x16 s4[4];
                float mx = NEGF;
#pragma unroll
                for (int t = 0; t < 4; ++t) {
                    if (t < nsub) {
                        const bool farc = TW - (16 * (32 * t + 31) + 31) >= 127;
                        s4[t] = splat16(farc ? c31 : 0.f);
                        bf16x8 kfc[4];
#pragma unroll
                        for (int ks = 0; ks < 4; ++ks) kfc[ks] = *(const LAS bf16x8*)(lds + OFF_KC + (32 * t + r) * KCS + 32 * ks + 16 * hh);
#pragma unroll
                        for (int ks = 0; ks < 4; ++ks) s4[t] = mfma32(kfc[ks], qf[ks], s4[t]);
                        if (!farc) {
                            const int d0 = tq - 31 - 16 * (32 * t + 4 * hh);
#pragma unroll
                            for (int i = 0; i < 16; ++i) {
                                const int dist = d0 - 16 * ((i & 3) + 8 * (i >> 2));
                                const float bias = mylut[dist < 0 ? 0 : (dist > 127 ? 127 : dist)];
                                s4[t][i] = dist >= 0 ? s4[t][i] + bias : NEGF;
                            }
                        }
#pragma unroll
                        for (int i = 0; i < 16; ++i) mx = fmaxf(mx, s4[t][i]);
                    }
                    __builtin_amdgcn_sched_barrier(0);
                }
                mx = fmaxf(mx, __shfl_xor(mx, 32));
                const float live = mx > -1e29f ? 1.f : 0.f;
                float sum = 0.f;
#pragma unroll
                for (int t = 0; t < 4; ++t) {
                    if (t < nsub) {
#pragma unroll
                        for (int i = 0; i < 16; ++i) { const float p = fexp2(s4[t][i] - mx) * live; s4[t][i] = p; sum += p; }
                    } else s4[t] = zero16();
                }
                sum += __shfl_xor(sum, 32);
                const float inv = sum > 0.f ? 1.f / sum : 0.f;
#pragma unroll
                for (int t = 0; t < 4; ++t) s4[t] *= inv;
                if (need_rank) {
                    float xprev = 0.f;
                    LAS float* irow = impw + (rhead * 64 + 32 * half + r) * 33;
#pragma unroll
                    for (int t = 0; t < 4; ++t)
#pragma unroll
                        for (int gq = 0; gq < 4; ++gq) {
                            const float a = (s4[t][4 * gq] + s4[t][4 * gq + 1]) + (s4[t][4 * gq + 2] + 0.5f * s4[t][4 * gq + 3]);
                            const float bc = 0.5f * s4[t][4 * gq + 3];
                            const float xc = __shfl_xor(bc, 32);
                            const float cin = hh ? xc : xprev; xprev = xc;
                            irow[8 * t + 2 * gq + hh] = a + cin;
                        }
                }
#pragma unroll
                for (int t = 0; t < 4; ++t) if (t < nsub) { s4[t] *= g0; pv_sub(lds + OFF_VC, VCS, 64 * t, s4[t], out, r, hh); }
            }
            const unsigned causal = (qblk >= 31) ? 0xffffffffu : ((2u << qblk) - 1u);
            unsigned mysel = causal, uni = causal;
            if (need_rank) {
                __syncthreads();
#pragma unroll
                for (int e = 0; e < 4; ++e) { const int idx = tid + 512 * e, tok = idx >> 5, j = idx & 31;
                    const float v = (impw[(0 * 64 + tok) * 33 + j] + impw[(1 * 64 + tok) * 33 + j]) + (impw[(2 * 64 + tok) * 33 + j] + impw[(3 * 64 + tok) * 33 + j]);
                    const bool forced = (j == 0) || (j == qblk) || (j == qblk - 1);
                    score[tok * 33 + j] = forced ? 1e6f : (j <= qblk ? v : -1e6f); }
                if (tid < 64) selm[tid] = 0u;
                __syncthreads();
#pragma nounroll
                for (int e = 0; e < 4; ++e) { const int idx = tid + 512 * e, tok = idx >> 5, j = idx & 31;
                    const float my = score[tok * 33 + j]; int rank = 0;
#pragma unroll 8
                    for (int j2 = 0; j2 < 32; ++j2) { const float o2 = score[tok * 33 + j2]; rank += (o2 > my || (o2 == my && j2 < j)) ? 1 : 0; }
                    if (rank < 16) atomicOr((unsigned*)(selm + tok), 1u << j); }
                __syncthreads();
                mysel = selm[32 * half + r] & causal;
                uni = selm[lane];
#pragma unroll
                for (int o = 1; o < 64; o <<= 1) uni |= __shfl_xor(uni, o);
                uni &= causal;
            }
#pragma nounroll
            for (int br = (PROBE_VARIANT == 4 && nrep == 0) ? 2 : 0; br < 2; ++br) {
                const bf16_t* Ksrc = slab + (size_t)(br ? 3 : 2) * SLAB_EL + bg * 2048 * 64;
                const bf16_t* Vsrc = VT2 + ((size_t)b * 512 + (br ? 256 : 0) + g * 64) * VPITCH;
                unsigned tiles;
                if (br == 0) tiles = uni; else { const int jlo = qblk - 8 < 0 ? 0 : qblk - 8; tiles = causal & ~((1u << jlo) - 1u); }
                float m = 0.f, l = 0.f; f32x16 o[2] = {zero16(), zero16()};
                u32x4 rk, rv;
                auto gload = [&](int j) {
                    rk = *(const u32x4*)(Ksrc + (size_t)j * 64 * 64 + (size_t)tid * 8);
                    rv = *(const u32x4*)(Vsrc + (size_t)(tid >> 3) * VPITCH + 64 * j + (tid & 7) * 8);
                };
                auto lstore = [&](int buf) {
                    LAS unsigned char* kb = lds + OFF_BUF + buf * TILE;
                    *(LAS u32x4*)(kb + (tid >> 3) * KS + (tid & 7) * 16) = rk;
                    lds_store16_as2x8(kb + VOFF + (tid >> 3) * VS + (tid & 7) * 16, rv);
                };
                auto process = [&](const LAS unsigned char* kb, int j) {
                    const int k0 = 64 * j;
                    const bool selbit = (br == 0) ? (((mysel >> j) & 1u) != 0u) : true;
                    if (br == 0 && __ballot(selbit) == 0ull) return;
                    const bool far = (TW - (k0 + 63) >= 127) && (br == 0 || (TW + 31 - k0 < 512));
                    f32x16 s[2];
                    qk_tile<4>(kb, KS, qf, s, r, hh, ref_frag(-m, far ? (selbit ? c31 : NEGF) : 0.f, hh));
                    if (!far) {
                        const int d0 = tq - k0 - 4 * hh;
#pragma unroll
                        for (int t = 0; t < 2; ++t)
#pragma unroll
                            for (int i = 0; i < 16; ++i) {
                                const int dist = d0 - (32 * t + (i & 3) + 8 * (i >> 2));
                                const float bias = mylut[dist < 0 ? 0 : (dist > 127 ? 127 : dist)];
                                const bool valid = selbit && dist >= 0 && (br == 0 || dist < 512);
                                s[t][i] = valid ? s[t][i] + bias : NEGF;
                            }
                    }
                    softmax_lazy(s, m, l, o, hh);
                    pv_sub(kb + VOFF, VS, 0, s[0], o, r, hh);
                    pv_sub(kb + VOFF, VS, 64, s[1], o, r, hh);
                };
                int j = __builtin_ctz(tiles); tiles &= tiles - 1;
                gload(j); lstore(0);
                int jn = -1; if (tiles) { jn = __builtin_ctz(tiles); tiles &= tiles - 1; gload(jn); }
                __syncthreads();
                int bi = 0;
                for (;;) {
                    const int bn = bi == 2 ? 0 : bi + 1;
                    if (jn >= 0) lstore(bn);
                    int jnn = -1; if (tiles) { jnn = __builtin_ctz(tiles); tiles &= tiles - 1; gload(jnn); }
                    process(lds + OFF_BUF + bi * TILE, j);
                    __syncthreads();
                    if (jn < 0) break;
                    j = jn; jn = jnn; bi = bn;
                }
                const float sc = (br ? g2 : g1) * frcp(l);
                out[0] += o[0] * sc; out[1] += o[1] * sc;
            }
            {
                const int l2 = opaque_tid(wv) & 63, tq2 = TW + (l2 & 31);
                store_ot(out, 1.f, O + ((size_t)b * SEQ + tq2) * 1024 + head * 64, l2 >> 5);
            }
        }
    }
}

#define XB_TMO      128
#define XB_XCNT(j)  (256  + 64 * (j))
#define XB_XSUB(j)  (1280 + 64 * (j))
#define XB_XGEN(j)  (2304 + 64 * (j))
#define XB_TOP      3328
#define XB_TOPGEN   3392
#define XCD_BAR_WORDS 3456
#define XB_SPIN_CAP (1u << 18)
DI unsigned xb_ld(unsigned* p)              { return __hip_atomic_load(p, __ATOMIC_RELAXED, __HIP_MEMORY_SCOPE_AGENT); }
DI unsigned xb_add(unsigned* p, unsigned v) { return __hip_atomic_fetch_add(p, v, __ATOMIC_RELAXED, __HIP_MEMORY_SCOPE_AGENT); }
DI unsigned xb_xcc_id() { return (unsigned)__builtin_amdgcn_s_getreg((3 << 11) | 20) & 0xFu; }
#define XB_SPIN(cond, bar) do { unsigned _sp = 0; while (cond) { __builtin_amdgcn_s_sleep(1); \
    if ((++_sp & 255u) == 0u) { if (xb_ld(&(bar)[XB_TMO])) break; if (_sp > XB_SPIN_CAP) { atomicAdd(&(bar)[XB_TMO], 1u); break; } } } } while (0)
DI void xcd_barrier_complete(unsigned* bar, unsigned x, unsigned& nloc, unsigned& nx) {
    const unsigned G = gridDim.x;
    unsigned sum, cnt, mine, sp = 0u;
    for (;;) {
        sum = 0u; cnt = 0u; mine = 0u;
#pragma unroll
        for (unsigned j = 0; j < 16; ++j) { const unsigned c = xb_ld(&bar[XB_XCNT(j)]); sum += c; cnt += (c > 0u) ? 1u : 0u; mine = (j == x) ? c : mine; }
        if (sum == G) break;
        __builtin_amdgcn_s_sleep(1);
        if ((++sp & 255u) == 0u) { if (xb_ld(&bar[XB_TMO])) break; if (sp > XB_SPIN_CAP) { atomicAdd(&bar[XB_TMO], 1u); break; } }
    }
    nloc = mine > 0u ? mine : 1u; nx = cnt > 0u ? cnt : 1u;
}
DI void xcd_barrier(int wv, unsigned* bar, volatile LAS unsigned* st) {
    asm volatile("s_waitcnt vmcnt(0)" ::: "memory");
    __syncthreads();
    if (opaque_tid(wv) == 0) {
        const unsigned x = xb_xcc_id();
        __builtin_amdgcn_s_waitcnt(0);
        unsigned nloc = st[0], nx = st[1];
        if (nloc == 0u) { xcd_barrier_complete(bar, x, nloc, nx); st[0] = nloc; st[1] = nx; }
        const unsigned old = xb_add(&bar[XB_XSUB(x)], 1u);
        const unsigned gen = old / nloc;
        if (old + 1u == (gen + 1u) * nloc) {
            __builtin_amdgcn_fence(__ATOMIC_RELEASE, "agent");
            asm volatile("s_waitcnt vmcnt(0)" ::: "memory");
            const unsigned og = xb_add(&bar[XB_TOP], 1u);
            const unsigned tg = og / nx;
            if (og + 1u == (tg + 1u) * nx) xb_add(&bar[XB_TOPGEN], 1u);
            else XB_SPIN(xb_ld(&bar[XB_TOPGEN]) == tg, bar);
            __builtin_amdgcn_fence(__ATOMIC_ACQUIRE, "agent");
            xb_add(&bar[XB_XGEN(x)], 1u);
            asm volatile("s_waitcnt vmcnt(0)" ::: "memory");
        } else {
            XB_SPIN(xb_ld(&bar[XB_XGEN(x)]) == gen, bar);
            __builtin_amdgcn_fence(__ATOMIC_ACQUIRE, "agent");
            asm volatile("s_waitcnt vmcnt(0)" ::: "memory");
        }
    }
    __syncthreads();
}

DI unsigned char* launder_ptr(unsigned char* p) { asm volatile("" : "+s"(p)); return p; }
__global__ void __launch_bounds__(512, 2) mega_fwd(Params P) {
    extern __shared__ __attribute__((aligned(16))) unsigned char lds_raw[];
    LAS unsigned char* lds = (LAS unsigned char*)lds_raw;
    cg::grid_group grid = cg::this_grid();
    const int wv = __builtin_amdgcn_readfirstlane((int)(threadIdx.x >> 6));
    const int lo = P.ph_lo, hi = P.ph_hi;
    int ph = 0;
    {
        volatile LAS unsigned* st = (volatile LAS unsigned*)(lds + LDS_GEMM);
        if (threadIdx.x == 0) { st[0] = 0u; st[1] = 0u; (void)xb_add(&((unsigned*)(P.ws + WS_BAR))[XB_XCNT(xb_xcc_id())], 1u); }
        __syncthreads();
    }
#define GRID_BAR() xcd_barrier(wv, (unsigned*)(launder_ptr(P.ws) + WS_BAR), (volatile LAS unsigned*)(lds + LDS_GEMM))
#define PH_BEGIN_C(cls) if (ph >= lo && ph < hi) { for (int _rep = 0; _rep < (((PROBE_MASK >> (cls)) & 1) ? 2 : 1); ++_rep) { if (_rep) GRID_BAR(); unsigned char* ws = launder_ptr(P.ws); bf16_t* Wb = (bf16_t*)(ws + WS_W); bf16_t* HB = (bf16_t*)(ws + WS_HB); float* SS = (float*)(ws + WS_SS); \
        float* SSQ = (float*)(ws + WS_SSQ); const float* rope = (const float*)(ws + WS_ROPE); unsigned char* big = ws + WS_BIG; bf16_t* Obuf = (bf16_t*)(big + B_O); const int G = gridDim.x, c = blockIdx.x; \
        (void)Wb; (void)HB; (void)SS; (void)SSQ; (void)rope; (void)big; (void)Obuf; (void)G; (void)c;
#define PH_END   } if (ph + 1 < hi) GRID_BAR(); } ++ph;
#define PH_END_CG } if (ph + 1 < hi) { if (lo < 0) grid.sync();   GRID_BAR(); } } ++ph;
#define PH_END_NOSYNC } } ++ph;

#if PROBE_VARIANT == 2
    for (int i = 0; i < 100; ++i) GRID_BAR();
#endif
    PH_BEGIN_C(0) p0_prologue(wv, P, lds); PH_END_CG

#pragma nounroll
    for (int L = 0; L < 4; ++L) {
#pragma nounroll
        for (int sub = 0; sub < 3; ++sub) {
            if (sub != 1) {
                PH_BEGIN_C(1)
                    bf16_t* wf = Wb + (size_t)(L * 2 + (sub >> 1)) * FFN_SZ;
                    pg8::Gemm g{HB, wf + FFN_WGU, M, 2 * FF, D, D, D}; pg8::StaticOrder<(M) / 256, (2 * FF) / 256> S; S.init(M, 2 * FF, G, c);
#if PROBE_VARIANT == 1
                    if (_rep == 0 && ((PROBE_MASK >> 1) & 1)) pg8::gemm_phase(wv, lds, g, S, EpiNull{(float*)(ws + WS_SSQ)}); else
#endif
                    pg8::gemm_phase(wv, lds, g, S, EpiSwiglu{SS, (bf16_t*)(big + B_HID)});
                PH_END
            } else if ((L & 1) == 0) {
                PH_BEGIN_C(2)
                    bf16_t* wm = Wb + W_MLA + (size_t)(L >> 1) * MLA_SZ;
                    pg8::Gemm g{HB, wm + MLA_WIN, M, 768, D, D, D}; pg8::StaticOrder<(M) / 256, (768) / 256> S; S.init(M, 768, G, c);
                    pg8::gemm_phase(wv, lds, g, S, EpiMlaIn{SS, (bf16_t*)(big + B_CQKV), SSQ, rope, (bf16_t*)(ws + WS_KR)});
                PH_END
                PH_BEGIN_C(3)
                    bf16_t* wm = Wb + W_MLA + (size_t)(L >> 1) * MLA_SZ;
                    bf16_t* CQKV = (bf16_t*)(big + B_CQKV);
                    { pg8::Gemm g{CQKV + 256, wm + MLA_WUQ, M, 1536, 384, 768, 384}; pg8::StaticOrder<(M) / 256, (1536) / 256> S; S.init(M, 1536, G, c);
                      pg8::gemm_phase(wv, lds, g, S, EpiMlaQ{SSQ, (bf16_t*)(big + B_MQ), rope}); }
                PH_END_NOSYNC
                PH_BEGIN_C(3)
                    bf16_t* wm = Wb + W_MLA + (size_t)(L >> 1) * MLA_SZ;
                    bf16_t* CQKV = (bf16_t*)(big + B_CQKV);
                    { pg8::Gemm g{CQKV, wm + MLA_WUKV, M, 1024, 256, 768, 256}; pg8::StaticOrder<(M) / 256, (1024) / 256> S; S.init(M, 1024, G, c);
                      pg8::gemm_phase(wv, lds, g, S, EpiRowStore<12, 0, 1>{SSQ, 1.f / 256.f, (bf16_t*)P.out  , 1024}); }
                PH_END_NOSYNC
                PH_BEGIN_C(3)
                    bf16_t* wm = Wb + W_MLA + (size_t)(L >> 1) * MLA_SZ;
                    bf16_t* CQKV = (bf16_t*)(big + B_CQKV);
                    { pg8::Gemm g{wm + MLA_WUKV + (size_t)1024 * 256, CQKV, 1024, M, 256, 256, 768}; pg8::StaticOrder<(1024) / 256, (M) / 256> S; S.init(1024, M, G, c);
                      pg8::gemm_phase(wv, lds, g, S, EpiColScale<12, 0, 1>{SSQ, 1.f / 256.f, (bf16_t*)(big + B_VT), (size_t)1024}); }
                PH_END
                PH_BEGIN_C(4)
#if PROBE_VARIANT >= 10
                    if (_rep == 0 && ((PROBE_MASK >> 4) & 1)) mla_attn_phase<PROBE_VARIANT - 10>(wv, lds, (const bf16_t*)(big + B_MQ), (const bf16_t*)P.out, (const bf16_t*)(ws + WS_KR), (const bf16_t*)(big + B_VT), Obuf); else
#endif
                    mla_attn_phase<0>(wv, lds, (const bf16_t*)(big + B_MQ), (const bf16_t*)P.out, (const bf16_t*)(ws + WS_KR), (const bf16_t*)(big + B_VT), Obuf);
                PH_END
            } else {
                PH_BEGIN_C(5)
                    bf16_t* wn = Wb + W_NSA + (size_t)(L >> 1) * NSA_SZ;
                    { pg8::Gemm g{HB, wn + NSA_WIN, M, 2304, D, D, D}; pg8::StaticOrder<(M) / 256, (2304) / 256> S; S.init(M, 2304, G, c);
                      pg8::gemm_phase(wv, lds, g, S, EpiNsaIn{SS, (bf16_t*)(big + B_NQ), (bf16_t*)(big + B_SLAB), (float*)(big + B_GATES)}); }
                    { pg8::Gemm g{wn + NSA_WIN + (size_t)2304 * 1024, HB, 512, M, D, D, D}; pg8::StaticOrder<(512) / 256, (M) / 256> S; S.init(512, M, G, c);
                      pg8::gemm_phase(wv, lds, g, S, EpiColScale<16, 0, 4>{SS, 1.f / 1024.f, (bf16_t*)(big + B_VT2), (size_t)512}); }
                PH_END
                PH_BEGIN_C(6)
                    bf16_t* wn = Wb + W_NSA + (size_t)(L >> 1) * NSA_SZ;
                    nsa_compress_phase(wv, lds, (const bf16_t*)(big + B_SLAB), wn, (const float*)(ws + WS_C1) + (L >> 1) * 256, (bf16_t*)(big + B_KCMP), (bf16_t*)(big + B_VCMPT));
                PH_END
                PH_BEGIN_C(7)
                    nsa_attn_phase(wv, lds, (const bf16_t*)(big + B_NQ), (const bf16_t*)(big + B_SLAB), (const bf16_t*)(big + B_VT2), (const float*)(big + B_GATES),
                                   (const bf16_t*)(big + B_KCMP), (const bf16_t*)(big + B_VCMPT), P.in[11], Obuf);
                PH_END
            }
            PH_BEGIN_C(9)
                const bf16_t* rA; const bf16_t* rB; int rK; float ralpha;
                if (sub != 1) { bf16_t* wf = Wb + (size_t)(L * 2 + (sub >> 1)) * FFN_SZ; rA = (const bf16_t*)(big + B_HID); rB = wf + FFN_WD; rK = FF; ralpha = 0.5f; }
                else if ((L & 1) == 0) { rA = Obuf; rB = Wb + W_MLA + (size_t)(L >> 1) * MLA_SZ + MLA_WO; rK = D; ralpha = 1.f; }
                else { rA = Obuf; rB = Wb + W_NSA + (size_t)(L >> 1) * NSA_SZ + NSA_WO; rK = D; ralpha = 1.f; }
                if (_rep == 0 && ((PROBE_MASK >> 9) & 1)) ralpha = 0.f;
                pg8::Gemm g{rA, rB, M, D, rK, rK, rK}; pg8::StaticOrder<(M) / 256, (D) / 256> S; S.init(M, D, G, c);
                pg8::gemm_phase(wv, lds, g, S, EpiResid{HB, SS, ralpha});
            PH_END
        }
    }
    PH_BEGIN_C(8) final_norm_phase(wv, P); PH_END
#undef PH_BEGIN_C
#undef PH_END
}
constexpr int N_PHASES = 1 + 4 * (2 + 4 + 2) + 2 * 2 + 1;

extern "C" void kernel_launch(void* const* d_in, const int* in_sizes, int n_in, void* d_out, int out_size, void* d_ws, size_t ws_size, hipStream_t stream) {
    static int grid = 0;
    if (grid == 0) {
        if (n_in != 26 || out_size != M * D || ws_size < WS_END) { fprintf(stderr, "kernel_launch: unexpected shapes (n_in %d out %d ws %zu need %zu)\n", n_in, out_size, ws_size, (size_t)WS_END); grid = -1; return; }
        int dev = 0, cus = 0, per_cu = 0;
        hipGetDevice(&dev); hipDeviceGetAttribute(&cus, hipDeviceAttributeMultiprocessorCount, dev);
        if (hipFuncSetAttribute((const void*)mega_fwd, hipFuncAttributeMaxDynamicSharedMemorySize, LDS_BYTES) != hipSuccess) { fprintf(stderr, "kernel_launch: hipFuncSetAttribute failed\n"); }
        hipOccupancyMaxActiveBlocksPerMultiprocessor(&per_cu, (const void*)mega_fwd, 512, LDS_BYTES);
        (void)hipGetLastError();
        if (per_cu < 1) per_cu = 1;
        grid = cus * 1;
        if (grid > 256) grid = 256;
        fprintf(stderr, "kernel_launch: grid %d (cus %d per_cu %d)\n", grid, cus, per_cu);
    }
    if (grid < 0) return;
    if (hipMemsetAsync((char*)d_ws + WS_BAR, 0, XCD_BAR_WORDS * 4, stream) != hipSuccess) { fprintf(stderr, "kernel_launch: memset of barrier words failed\n"); return; }
    Params p{};
    for (int i = 0; i < 26; ++i) p.in[i] = (const float*)d_in[i];
    p.out = (float*)d_out; p.ws = (unsigned char*)d_ws;
#if MK_PER_PHASE
    for (int ph = 0; ph < N_PHASES; ++ph) {
        p.ph_lo = ph; p.ph_hi = ph + 1;
        hipLaunchKernelGGL(mega_fwd, dim3(grid), dim3(512), LDS_BYTES, stream, p);
    }
#else
    p.ph_lo = 0; p.ph_hi = N_PHASES;
    void* args[] = {&p};
    hipError_t e = hipLaunchCooperativeKernel((const void*)mega_fwd, dim3(grid), dim3(512), args, LDS_BYTES, stream);
    if (e != hipSuccess) fprintf(stderr, "cooperative launch failed: %s (grid %d)\n", hipGetErrorString(e), grid);
#endif
}
```

```cpp
#include <hip/hip_runtime.h>
#include <hip/hip_cooperative_groups.h>
#include <cstdio>
#include <cstdint>
namespace cg = cooperative_groups;

#ifndef MK_PER_PHASE
#define MK_PER_PHASE 0
#endif
#ifndef PROBE_VARIANT
#define PROBE_VARIANT 0
#endif
#ifndef PROBE_MASK
#define PROBE_MASK 0
#endif

#define DI __device__ __forceinline__
#define LAS __attribute__((address_space(3)))
typedef unsigned short bf16_t;
typedef short bf16x8 __attribute__((ext_vector_type(8)));
typedef float f32x4 __attribute__((ext_vector_type(4)));
typedef float f32x16 __attribute__((ext_vector_type(16)));
typedef unsigned u32x4 __attribute__((ext_vector_type(4)));
typedef unsigned u32x2 __attribute__((ext_vector_type(2)));

constexpr int M = 32768, D = 1024, FF = 2816, SEQ = 2048, NB = 16;
constexpr float LOG2E = 1.4426950408889634f;
constexpr float NEGF = -1e30f;
constexpr float EPS = 1e-6f;
constexpr int LDS_GEMM = 131072;
constexpr int LDS_RS = LDS_GEMM + 16;
constexpr int LDS_BYTES = LDS_RS + 512 * 32;

constexpr size_t MiB = (size_t)1 << 20;
constexpr size_t WS_ROPE = 0;
constexpr size_t WS_C1 = 512 * 1024;
constexpr size_t WS_BAR = 768 * 1024;
constexpr size_t WS_SS = 1 * MiB;
constexpr size_t WS_SSQ = 3 * MiB;
constexpr size_t WS_HB = 5 * MiB;
constexpr size_t WS_W = 69 * MiB;
constexpr size_t WS_BIG = 230 * MiB;
constexpr size_t WS_KR = WS_BIG + 274 * MiB;
constexpr size_t WS_END = WS_KR + 2 * MiB;
constexpr int VPITCH = 2048 + 64;
constexpr size_t FFN_WGU = 0, FFN_WD = (size_t)5632 * 1024, FFN_SZ = FFN_WD + (size_t)1024 * 2816;
constexpr size_t W_MLA = 8 * FFN_SZ;
constexpr size_t MLA_WIN = 0, MLA_WUQ = MLA_WIN + 768 * 1024, MLA_WUKV = MLA_WUQ + 1536 * 384, MLA_WO = MLA_WUKV + 2048 * 256, MLA_SZ = MLA_WO + 1024 * 1024;
constexpr size_t W_NSA = W_MLA + 2 * MLA_SZ;
constexpr size_t NSA_WIN = 0, NSA_W1K = NSA_WIN + 2816 * 1024, NSA_W1V = NSA_W1K + 128 * 2048, NSA_W2K = NSA_W1V + 128 * 2048, NSA_W2V = NSA_W2K + 64 * 128, NSA_WO = NSA_W2V + 64 * 128, NSA_SZ = NSA_WO + 1024 * 1024;
static_assert((W_NSA + 2 * NSA_SZ) * 2 <= 161 * MiB, "weights region");
static_assert((size_t)16 * 1024 * (2048 + 64) * 2 <= 66 * MiB && (size_t)16 * 512 * (2048 + 64) * 2 <= 33 * MiB, "V^T regions");
constexpr size_t B_HID = 0;
constexpr size_t B_CQKV = 0, B_MQ = 48 * MiB, B_VT = 144 * MiB  , B_O = 210 * MiB;
constexpr size_t B_NQ = 0, B_SLAB = 64 * MiB  , B_VT2 = 128 * MiB  , B_GATES = 161 * MiB, B_KCMP = 168 * MiB, B_VCMPT = 169 * MiB;
constexpr size_t SLAB_EL = (size_t)M * 256;

DI unsigned pk2(float lo, float hi) {
    typedef __bf16 bf2 __attribute__((ext_vector_type(2)));
    bf2 v; v[0] = (__bf16)lo; v[1] = (__bf16)hi; return __builtin_bit_cast(unsigned, v);
}
DI u32x4 pk8(f32x4 a, f32x4 b) { u32x4 o; o.x = pk2(a.x, a.y); o.y = pk2(a.z, a.w); o.z = pk2(b.x, b.y); o.w = pk2(b.z, b.w); return o; }
DI int opaque_tid(int wv) { unsigned ones = ~0u; asm volatile("" : "+s"(ones)); int t = wv * 64 + (int)__builtin_amdgcn_mbcnt_hi(ones, __builtin_amdgcn_mbcnt_lo(ones, 0u)); asm volatile("" : "+v"(t)); return t; }
DI int opaque_tid_full() { return (int)threadIdx.x; }
DI int launder_v(int v) { asm volatile("" : "+v"(v)); return v; }
DI float fexp2(float x) { return __builtin_amdgcn_exp2f(x); }
DI float frcp(float x) { return __builtin_amdgcn_rcpf(x); }
DI float sigmoidf_(float x) { return frcp(1.f + fexp2(-x * LOG2E)); }
template <int STRIDE, int P0, int NP4>
DI float rstd_parts(const float* parts, size_t row, float invK) {
    const f32x4* p = (const f32x4*)(parts + row * STRIDE + P0); float s = 0.f;
#pragma unroll
    for (int i = 0; i < NP4; ++i) { f32x4 v = p[i]; s += (v.x + v.y) + (v.z + v.w); }
    return rsqrtf(s * invK + EPS);
}
#define EPI_SCHED() __builtin_amdgcn_sched_barrier(0)

namespace pg8 {
constexpr int BM = 256, BK = 64, HALF = 128, HTB = HALF * BK * 2, STAGE_BYTES = 8 * HTB, NXCD = 8, WGM = 8;
__host__ __device__ __forceinline__ int lds_byte(int r, int c) { const int st = (r >> 4) * 2 + (c >> 5), rr = r & 15, cc = c & 31, ob = rr * 64 + cc * 2; return st * 1024 + (ob ^ (((ob >> 9) & 1) << 5)); }
__host__ __device__ __forceinline__ void stage_rc(int b, int& R, int& C) { const int st = b / 1024, sb = b % 1024, swz = sb ^ (((sb >> 9) & 1) << 5); R = (st >> 1) * 16 + swz / 64; C = (st & 1) * 32 + (swz % 64) / 2; }
__host__ __device__ __forceinline__ int perm32(int rho) { const int n = rho >> 4, i = rho & 15; return 8 * (i >> 2) + 4 * n + (i & 3); }
struct Unit { int pm, pn; };
struct Gemm { const bf16_t* A; const bf16_t* Bt; int M, N, K, lda, ldb; };
template <int NM, int NN>
struct StaticOrder {
    static constexpr int nM = NM, nN = NN, nwg = NM * NN;
    int G, c;
    DI void init(int, int, int G_, int c_) { G = G_; c = c_; }
    DI bool next(int i, Unit& u) const {
        const int L = i * G + c; if (L >= nwg) return false;
        int wgid = L; { constexpr int q = nwg / NXCD, r = nwg % NXCD; const int xcd = wgid % NXCD, off = wgid / NXCD; wgid = (xcd < r ? xcd * (q + 1) : r * (q + 1) + (xcd - r) * q) + off; }
        constexpr int nig = WGM * nN; const int gid = wgid / nig, fm = gid * WGM, gsz = (nM - fm) < WGM ? (nM - fm) : WGM;
        u.pm = fm + ((wgid % nig) % gsz); u.pn = (wgid % nig) / gsz; return true;
    }
};
template <class T, class = void> struct epi_prefetch { static constexpr bool value = false; };
template <class T> struct epi_prefetch<T, decltype((void)T::PREFETCH)> { static constexpr bool value = T::PREFETCH; };
template <class Epi, class Sched>
DI void gemm_phase(int wv, LAS unsigned char* lds, const Gemm g, const Sched& S, const Epi& E) {
    const int tid = opaque_tid(wv), wid = __builtin_amdgcn_readfirstlane(tid >> 6), lane = tid & 63, wr = wid >> 2, wc = wid & 3, fr = lane & 15, fq = lane >> 4;
    const int K = g.K, nt = K / BK;
    unsigned voffA[2], voffB[2];
#pragma unroll
    for (int i = 0; i < 2; ++i) { int R, C; stage_rc(tid * 16 + i * 8192, R, C); const int Rb = (R & ~31) + perm32(R & 31);
        voffA[i] = (unsigned)(R * g.lda + C) * 2u; voffB[i] = (unsigned)(Rb * g.ldb + C) * 2u; }
    const size_t kstep = (size_t)(BK * 2);
    const size_t hstepA = (size_t)HALF * g.lda * 2, hstepB = (size_t)HALF * g.ldb * 2;
    const size_t tstepA = 2 * hstepA, tstepB = 2 * hstepB;
    const unsigned ldsw = (unsigned)wid * 1024u;
    const int aoff = lds_byte(wr * 64 + fr, fq * 8), boff = lds_byte(wc * 32 + fr, fq * 8);
#define PG8_SA(b, h) (((b) * 2 + (h)) * HTB)
#define PG8_SB(b, h) ((4 + (b) * 2 + (h)) * HTB)
#define PG8_STAGE(bufoff, gbase, voff) do { const char* _gb = (const char*)(gbase); asm volatile("" : "+s"(_gb)); _Pragma("unroll") for (int _i = 0; _i < 2; ++_i) { \
        unsigned _vo = (voff)[_i]; asm volatile("" : "+v"(_vo));     \
        __builtin_amdgcn_global_load_lds((const unsigned*)(_gb + _vo), (LAS unsigned*)(lds + (bufoff) + ldsw + _i * 8192), 16, 0, 0); } } while (0)
#define PG8_LDA(dst, b, h) do { _Pragma("unroll") for (int m = 0; m < 4; ++m) _Pragma("unroll") for (int k = 0; k < 2; ++k) dst[m][k] = *(const LAS bf16x8*)(lds + PG8_SA(b, h) + aoff + m * 2048 + k * 1024); } while (0)
#define PG8_LDB(dst, b, h) do { _Pragma("unroll") for (int n = 0; n < 2; ++n) _Pragma("unroll") for (int k = 0; k < 2; ++k) dst[n][k] = *(const LAS bf16x8*)(lds + PG8_SB(b, h) + boff + n * 2048 + k * 1024); } while (0)
#define PG8_MMA(ai, bj, At, Bt) do { __builtin_amdgcn_s_setprio(1); _Pragma("unroll") for (int m = 0; m < 4; ++m) _Pragma("unroll") for (int n = 0; n < 2; ++n) _Pragma("unroll") for (int k = 0; k < 2; ++k) \
        acc[ai][bj][m][n] = __builtin_amdgcn_mfma_f32_16x16x32_bf16(Bt[n][k], At[m][k], acc[ai][bj][m][n], 0, 0, 0); __builtin_amdgcn_s_setprio(0); } while (0)
#define PG8_WAIT_V(n) asm volatile("s_waitcnt vmcnt(" #n ")" ::: "memory")
#define PG8_WAIT_L(n) asm volatile("s_waitcnt lgkmcnt(" #n ")" ::: "memory")
#define PG8_BAR __builtin_amdgcn_s_barrier()
#define PG8_SCHED __builtin_amdgcn_sched_barrier(0)
    Unit cur, nxt; int ui = 0;
    if (!S.next(0, cur)) return;
    f32x4 acc[2][2][4][2];
#pragma unroll
    for (int a = 0; a < 2; ++a)
#pragma unroll
        for (int b = 0; b < 2; ++b)
#pragma unroll
            for (int m = 0; m < 4; ++m)
#pragma unroll
                for (int n = 0; n < 2; ++n) acc[a][b][m][n] = (f32x4){0.f, 0.f, 0.f, 0.f};
    bf16x8 At[4][2], B0[2][2], B1[2][2];
    const char* cA = (const char*)g.A + (size_t)cur.pm * tstepA; const char* cB = (const char*)g.Bt + (size_t)cur.pn * tstepB;
    float rsn[2][4];
    if constexpr (epi_prefetch<Epi>::value) E.pre(cur, wr, wc, fr, fq, rsn);
    PG8_STAGE(PG8_SB(0, 0), cB, voffB); PG8_STAGE(PG8_SB(0, 1), cB + hstepB, voffB); PG8_STAGE(PG8_SA(0, 0), cA, voffA); PG8_STAGE(PG8_SA(0, 1), cA + hstepA, voffA);
    if (wr == 1) PG8_BAR;
    PG8_WAIT_V(2); PG8_BAR;
    PG8_STAGE(PG8_SB(1, 0), cB + kstep, voffB); PG8_STAGE(PG8_SA(1, 0), cA + kstep, voffA); PG8_STAGE(PG8_SB(1, 1), cB + hstepB + kstep, voffB);
    PG8_WAIT_V(6); PG8_BAR;
    for (;;) {
        const bool has_next = S.next(ui + 1, nxt);
        const char* nA = has_next ? (const char*)g.A + (size_t)nxt.pm * tstepA : cA; const char* nB = has_next ? (const char*)g.Bt + (size_t)nxt.pn * tstepB : cB;
#pragma nounroll
        for (int t = 0; t < nt; t += 2) {
            const bool last = (t == nt - 2);
            const char* a1 = cA + (size_t)(t + 1) * kstep;
            const char* a2 = last ? nA : cA + (size_t)(t + 2) * kstep; const char* b2 = last ? nB : cB + (size_t)(t + 2) * kstep;
            const char* a3 = a2 + kstep; const char* b3 = b2 + kstep;
            PG8_LDB(B0, 0, 0); PG8_LDB(B1, 0, 1); PG8_SCHED; PG8_LDA(At, 0, 0); PG8_STAGE(PG8_SA(1, 1), a1 + hstepA, voffA);
            PG8_WAIT_V(8); PG8_WAIT_L(0); PG8_BAR; PG8_MMA(0, 0, At, B0); PG8_MMA(0, 1, At, B1); PG8_BAR; PG8_SCHED;
            PG8_LDA(At, 0, 1); PG8_STAGE(PG8_SB(0, 0), b2, voffB); PG8_STAGE(PG8_SB(0, 1), b2 + hstepB, voffB); PG8_STAGE(PG8_SA(0, 0), a2, voffA);
            PG8_WAIT_V(8); PG8_WAIT_L(0); PG8_BAR; PG8_MMA(1, 0, At, B0); PG8_MMA(1, 1, At, B1); PG8_BAR; PG8_SCHED;
            PG8_LDB(B0, 1, 0); PG8_LDB(B1, 1, 1); PG8_SCHED; PG8_LDA(At, 1, 0); PG8_STAGE(PG8_SA(0, 1), a2 + hstepA, voffA);
            PG8_WAIT_V(8); PG8_WAIT_L(0); PG8_BAR; PG8_MMA(0, 0, At, B0); PG8_MMA(0, 1, At, B1); PG8_BAR; PG8_SCHED;
            PG8_LDA(At, 1, 1); PG8_STAGE(PG8_SB(1, 0), b3, voffB); PG8_STAGE(PG8_SB(1, 1), b3 + hstepB, voffB); PG8_STAGE(PG8_SA(1, 0), a3, voffA);
            PG8_WAIT_V(8); PG8_WAIT_L(0); PG8_BAR; PG8_MMA(1, 0, At, B0); PG8_MMA(1, 1, At, B1); PG8_BAR; PG8_SCHED;
        }
        PG8_SCHED;
        if (wr == 0) PG8_BAR;
        { const int l2 = opaque_tid(0);
          if constexpr (epi_prefetch<Epi>::value) E(acc, cur, nxt, has_next, wr, wc, l2 & 15, l2 >> 4, rsn); else E(acc, cur, wr, wc, l2 & 15, l2 >> 4); }
        if (!has_next) break;
#pragma unroll
        for (int a = 0; a < 2; ++a)
#pragma unroll
            for (int b = 0; b < 2; ++b)
#pragma unroll
                for (int m = 0; m < 4; ++m)
#pragma unroll
                    for (int n = 0; n < 2; ++n) acc[a][b][m][n] = (f32x4){0.f, 0.f, 0.f, 0.f};
        cur = nxt; cA = nA; cB = nB; ++ui;
        if (wr == 1) PG8_BAR;
    }
    PG8_WAIT_V(0);
    PG8_BAR;
#undef PG8_SA
#undef PG8_SB
#undef PG8_STAGE
#undef PG8_LDA
#undef PG8_LDB
#undef PG8_MMA
#undef PG8_WAIT_V
#undef PG8_WAIT_L
#undef PG8_BAR
#undef PG8_SCHED
}
}
using pg8::Unit;
typedef f32x4 AccT[2][2][4][2];

template <int STRIDE, int P0, int NP4>
DI void rstd8(const float* parts, size_t row0, float invK, int fq, float (&rs)[2][4]) {
    f32x4 v[2][4];
#pragma unroll
    for (int ai = 0; ai < 2; ++ai)
#pragma unroll
        for (int m = 0; m < 4; ++m) {
            const float* p = parts + (row0 + ai * 128 + m * 16) * STRIDE + P0;
            if (NP4 == 1) v[ai][m] = *(const f32x4*)p;
            else if (fq < NP4) v[ai][m] = *(const f32x4*)(p + 4 * fq);
            else v[ai][m] = (f32x4){0.f, 0.f, 0.f, 0.f};
        }
#pragma unroll
    for (int ai = 0; ai < 2; ++ai)
#pragma unroll
        for (int m = 0; m < 4; ++m) {
            float t = (v[ai][m].x + v[ai][m].y) + (v[ai][m].z + v[ai][m].w);
            if (NP4 > 1) { t += __shfl_xor(t, 16); t += __shfl_xor(t, 32); }
            rs[ai][m] = rsqrtf(t * invK + EPS);
        }
}
struct EpiNull {
    float* sink;
    DI void operator()(const AccT& acc, const Unit& u, int wr, int wc, int fr, int fq) const {
        f32x4 t = acc[0][0][0][0];
#pragma unroll
        for (int ai = 0; ai < 2; ++ai)
#pragma unroll
            for (int bj = 0; bj < 2; ++bj)
#pragma unroll
                for (int m = 0; m < 4; ++m)
#pragma unroll
                    for (int n = 0; n < 2; ++n) t += acc[ai][bj][m][n];
        if (t.x == 12345.678f) sink[0] = t.y + t.z + t.w;
    }
};
struct EpiSwiglu {
    static constexpr bool PREFETCH = true;
    const float* ss; bf16_t* hid;
    DI void pre(const Unit& u, int wr, int wc, int fr, int fq, float (&rs)[2][4]) const { rstd8<16, 0, 4>(ss, (size_t)u.pm * 256 + wr * 64 + fr, 1.f / 1024.f, fq, rs); park(rs, (wr * 4 + wc) * 64 + fq * 16 + fr); }
    DI static LAS f32x4* slot(int t) { extern __shared__ __attribute__((aligned(16))) unsigned char lds_raw_[]; return (LAS f32x4*)((LAS unsigned char*)lds_raw_ + LDS_RS) + 2 * t; }
    DI static void park(const float (&rs)[2][4], int t) { LAS f32x4* p = slot(t); p[0] = (f32x4){rs[0][0], rs[0][1], rs[0][2], rs[0][3]}; p[1] = (f32x4){rs[1][0], rs[1][1], rs[1][2], rs[1][3]}; }
    DI static void unpark(float (&rs)[2][4], int t) { const LAS f32x4* p = slot(t); const f32x4 a = p[0], b = p[1]; rs[0][0] = a.x; rs[0][1] = a.y; rs[0][2] = a.z; rs[0][3] = a.w; rs[1][0] = b.x; rs[1][1] = b.y; rs[1][2] = b.z; rs[1][3] = b.w; }
    DI void operator()(const AccT& acc, const Unit& u, const Unit& nxt, bool has_next, int wr, int wc, int fr, int fq, float (&rs_unused)[2][4]) const {
        const size_t row0 = (size_t)u.pm * 256 + wr * 64 + fr;
        const int myt = (wr * 4 + wc) * 64 + fq * 16 + fr;
        float rs[2][4]; unpark(rs, myt);
        f32x4 nv[2][4];
        if (has_next) {
            const size_t nrow0 = (size_t)nxt.pm * 256 + wr * 64 + fr;
#pragma unroll
            for (int ai = 0; ai < 2; ++ai)
#pragma unroll
                for (int m = 0; m < 4; ++m) nv[ai][m] = *(const f32x4*)(ss + (nrow0 + ai * 128 + m * 16) * 16 + 4 * fq);
        }
#pragma unroll
        for (int ai = 0; ai < 2; ++ai)
#pragma unroll
            for (int m = 0; m < 4; ++m) {
                EPI_SCHED(); const size_t row = row0 + ai * 128 + m * 16;
                f32x4 o[2];
                const float c1 = -LOG2E * rs[ai][m], rs2 = rs[ai][m] * rs[ai][m];
#pragma unroll
                for (int n = 0; n < 2; ++n) {
                    const f32x4 gt = acc[ai][0][m][n], t = gt * acc[ai][1][m][n];
#pragma unroll
                    for (int e = 0; e < 4; ++e) o[n][e] = t[e] * (rs2 * frcp(1.f + fexp2(gt[e] * c1)));
                }
                *(u32x4*)(hid + row * FF + u.pn * 128 + wc * 32 + fq * 8) = pk8(o[0], o[1]);
            }
        if (has_next) {
#pragma unroll
            for (int ai = 0; ai < 2; ++ai)
#pragma unroll
                for (int m = 0; m < 4; ++m) {
                    float t = (nv[ai][m].x + nv[ai][m].y) + (nv[ai][m].z + nv[ai][m].w);
                    t += __shfl_xor(t, 16); t += __shfl_xor(t, 32);
                    rs[ai][m] = rsqrtf(t * (1.f / 1024.f) + EPS);
                }
            park(rs, myt);
        }
    }
};
struct EpiResid {
    bf16_t* hb; float* ss; float alpha;
    DI void operator()(const AccT& acc, const Unit& u, int wr, int wc, int fr, int fq) const {
        const size_t row0 = (size_t)u.pm * 256 + wr * 64 + fr;
        const int col0 = u.pn * 256 + wc * 32 + fq * 8;
#pragma unroll
        for (int ai = 0; ai < 2; ++ai) {
            EPI_SCHED();
            u32x4 hv[4][2];
#pragma unroll
            for (int m = 0; m < 4; ++m)
#pragma unroll
                for (int bj = 0; bj < 2; ++bj) hv[m][bj] = *(const u32x4*)(hb + (row0 + ai * 128 + m * 16) * D + col0 + bj * 128);
#pragma unroll
            for (int m = 0; m < 4; ++m) {
                const size_t row = row0 + ai * 128 + m * 16;
                float sq = 0.f;
#pragma unroll
                for (int bj = 0; bj < 2; ++bj) {
                    const u32x4 w = hv[m][bj];
                    f32x4 a, b;
                    a.x = __uint_as_float(w.x << 16); a.y = __uint_as_float(w.x & 0xffff0000u); a.z = __uint_as_float(w.y << 16); a.w = __uint_as_float(w.y & 0xffff0000u);
                    b.x = __uint_as_float(w.z << 16); b.y = __uint_as_float(w.z & 0xffff0000u); b.z = __uint_as_float(w.w << 16); b.w = __uint_as_float(w.w & 0xffff0000u);
                    a += acc[ai][bj][m][0] * alpha; b += acc[ai][bj][m][1] * alpha;
                    sq += (a.x * a.x + a.y * a.y) + (a.z * a.z + a.w * a.w) + (b.x * b.x + b.y * b.y) + (b.z * b.z + b.w * b.w);
                    *(u32x4*)(hb + row * D + col0 + bj * 128) = pk8(a, b);
                }
                sq += __shfl_xor(sq, 16); sq += __shfl_xor(sq, 32);
                if (fq == 0) ss[row * 16 + u.pn * 4 + wc] = sq;
            }
        }
    }
};
DI void rope4(f32x4& v0, f32x4& v1, const f32x4 c, const f32x4 s) {
    f32x4 a = v0, b = v1;
    v0.x = a.x * c.x - a.y * s.x; v0.y = a.x * s.x + a.y * c.x;
    v0.z = a.z * c.y - a.w * s.y; v0.w = a.z * s.y + a.w * c.y;
    v1.x = b.x * c.z - b.y * s.z; v1.y = b.x * s.z + b.y * c.z;
    v1.z = b.z * c.w - b.w * s.w; v1.w = b.z * s.w + b.w * c.w;
}
struct EpiMlaIn {
    const float* ss; bf16_t* cqkv; float* ssq; const float* rope; bf16_t* kr;
    DI void operator()(const AccT& acc, const Unit& u, int wr, int wc, int fr, int fq) const {
        const size_t row0 = (size_t)u.pm * 256 + wr * 64 + fr;
        float rs[2][4]; rstd8<16, 0, 4>(ss, row0, 1.f / 1024.f, fq, rs);
        const bool do_rope = (u.pn == 2) && (wc == 0);
#pragma unroll
        for (int ai = 0; ai < 2; ++ai) {
            EPI_SCHED();
            f32x4 cs[4], sn[4];
            if (do_rope) {
#pragma unroll
                for (int m = 0; m < 4; ++m) { const int s = (int)((row0 + ai * 128 + m * 16) & 2047); cs[m] = *(const f32x4*)(rope + s * 16 + 4 * fq); sn[m] = *(const f32x4*)(rope + 32768 + s * 16 + 4 * fq); }
            }
#pragma unroll
            for (int m = 0; m < 4; ++m) {
                const size_t row = row0 + ai * 128 + m * 16;
                float sq = 0.f;
#pragma unroll
                for (int bj = 0; bj < 2; ++bj) {
                    const int col = u.pn * 256 + bj * 128 + wc * 32 + fq * 8;
                    f32x4 a = acc[ai][bj][m][0] * rs[ai][m], b = acc[ai][bj][m][1] * rs[ai][m];
                    if (u.pn == 2 && bj == 1) {
                        if (wc == 0) { rope4(a, b, cs[m], sn[m]); *(u32x4*)(kr + row * 32 + fq * 8) = pk8(a, b); }
                    } else {
                        sq += (a.x * a.x + a.y * a.y) + (a.z * a.z + a.w * a.w) + (b.x * b.x + b.y * b.y) + (b.z * b.z + b.w * b.w);
                        *(u32x4*)(cqkv + row * 768 + col) = pk8(a, b);
                    }
                }
                sq += __shfl_xor(sq, 16); sq += __shfl_xor(sq, 32);
                if (fq == 0) ssq[row * 12 + u.pn * 4 + wc] = sq;
            }
        }
    }
};
struct EpiMlaQ {
    const float* ssq; bf16_t* q; const float* rope;
    DI void operator()(const AccT& acc, const Unit& u, int wr, int wc, int fr, int fq) const {
        const size_t row0 = (size_t)u.pm * 256 + wr * 64 + fr;
        float rs[2][4]; rstd8<12, 4, 2>(ssq, row0, 1.f / 384.f, fq, rs);
#pragma unroll
        for (int bj = 0; bj < 2; ++bj) {
            const int col = u.pn * 256 + bj * 128 + wc * 32 + fq * 8;
            const int d0 = col % 96; const bool do_rope = d0 >= 64; const int i0 = do_rope ? (d0 - 64) >> 1 : 0;
#pragma unroll
            for (int ai = 0; ai < 2; ++ai) {
                EPI_SCHED();
                f32x4 cs[4], sn[4];
                if (do_rope) {
#pragma unroll
                    for (int m = 0; m < 4; ++m) { const int s = (int)((row0 + ai * 128 + m * 16) & 2047); cs[m] = *(const f32x4*)(rope + s * 16 + i0); sn[m] = *(const f32x4*)(rope + 32768 + s * 16 + i0); }
                }
#pragma unroll
                for (int m = 0; m < 4; ++m) {
                    const size_t row = row0 + ai * 128 + m * 16;
                    f32x4 a = acc[ai][bj][m][0] * rs[ai][m], b = acc[ai][bj][m][1] * rs[ai][m];
                    if (do_rope) rope4(a, b, cs[m], sn[m]);
                    *(u32x4*)(q + row * 1536 + col) = pk8(a, b);
                }
            }
        }
    }
};
template <int STRIDE, int P0, int NP4>
struct EpiRowStore {
    const float* parts; float invK; bf16_t* out; int ldo;
    DI void operator()(const AccT& acc, const Unit& u, int wr, int wc, int fr, int fq) const {
        const size_t row0 = (size_t)u.pm * 256 + wr * 64 + fr;
        float rs[2][4]; rstd8<STRIDE, P0, NP4>(parts, row0, invK, fq, rs);
#pragma unroll
        for (int ai = 0; ai < 2; ++ai)
#pragma unroll
            for (int m = 0; m < 4; ++m) {
                EPI_SCHED(); const size_t row = row0 + ai * 128 + m * 16;
#pragma unroll
                for (int bj = 0; bj < 2; ++bj) {
                    const int col = u.pn * 256 + bj * 128 + wc * 32 + fq * 8;
                    const unsigned off = ((unsigned)(row >> 11) * 32768u + (unsigned)(row & 2047)) * 64u + (unsigned)(col >> 6) * 131072u + (unsigned)(col & 63);
                    *(u32x4*)(out + off) = pk8(acc[ai][bj][m][0] * rs[ai][m], acc[ai][bj][m][1] * rs[ai][m]);
                }
            }
    }
};
template <int STRIDE, int P0, int NP4>
struct EpiColScale {
    const float* parts; float invK; bf16_t* out; size_t nrows;
    DI void operator()(const AccT& acc, const Unit& u, int wr, int wc, int fr, int fq) const {
#pragma unroll
        for (int bj = 0; bj < 2; ++bj) {
            EPI_SCHED();
            const size_t col = (size_t)u.pn * 256 + bj * 128 + wc * 32 + fq * 8;
            f32x4 c0, c1;
            if (NP4 == 1) {
                f32x4 v[8];
#pragma unroll
                for (int e = 0; e < 8; ++e) v[e] = *(const f32x4*)(parts + (col + e) * STRIDE + P0);
#pragma unroll
                for (int e = 0; e < 4; ++e) { c0[e] = rsqrtf(((v[e].x + v[e].y) + (v[e].z + v[e].w)) * invK + EPS); c1[e] = rsqrtf(((v[4 + e].x + v[4 + e].y) + (v[4 + e].z + v[4 + e].w)) * invK + EPS); }
            } else {
#pragma unroll
                for (int hb2 = 0; hb2 < 2; ++hb2) {
                    f32x4 v[4][NP4];
#pragma unroll
                    for (int e = 0; e < 4; ++e)
#pragma unroll
                        for (int i = 0; i < NP4; ++i) v[e][i] = *(const f32x4*)(parts + (col + 4 * hb2 + e) * STRIDE + P0 + 4 * i);
#pragma unroll
                    for (int e = 0; e < 4; ++e) { float t = 0.f;
#pragma unroll
                        for (int i = 0; i < NP4; ++i) t += (v[e][i].x + v[e][i].y) + (v[e][i].z + v[e][i].w);
                        const float r = rsqrtf(t * invK + EPS); if (hb2 == 0) c0[e] = r; else c1[e] = r; }
                    EPI_SCHED();
                }
            }
#pragma unroll
            for (int ai = 0; ai < 2; ++ai)
#pragma unroll
                for (int m = 0; m < 4; ++m) {
                    const size_t row = (size_t)u.pm * 256 + ai * 128 + wr * 64 + m * 16 + fr;
                    *(u32x4*)(out + ((col >> 11) * nrows + row) * VPITCH + (col & 2047)) = pk8(acc[ai][bj][m][0] * c0, acc[ai][bj][m][1] * c1);
                }
        }
    }
};
struct EpiNsaIn {
    const float* ss; bf16_t* q; bf16_t* slab; float* gates;
    DI void operator()(const AccT& acc, const Unit& u, int wr, int wc, int fr, int fq) const {
        const size_t row0 = (size_t)u.pm * 256 + wr * 64 + fr;
        float rs[2][4]; rstd8<16, 0, 4>(ss, row0, 1.f / 1024.f, fq, rs);
#pragma unroll
        for (int ai = 0; ai < 2; ++ai)
#pragma unroll
            for (int m = 0; m < 4; ++m) {
                EPI_SCHED(); const size_t row = row0 + ai * 128 + m * 16;
                const size_t b = row >> 11, s = row & 2047;
#pragma unroll
                for (int bj = 0; bj < 2; ++bj) {
                    const int cc = bj * 128 + wc * 32 + fq * 8;
                    f32x4 a = acc[ai][bj][m][0] * rs[ai][m], c = acc[ai][bj][m][1] * rs[ai][m];
                    if (u.pn < 4) *(u32x4*)(q + row * 1024 + u.pn * 256 + cc) = pk8(a, c);
                    else if (u.pn < 8) { const int g = cc >> 6, d = cc & 63; *(u32x4*)(slab + (size_t)(u.pn - 4) * SLAB_EL + ((b * 4 + g) * 2048 + s) * 64 + d) = pk8(a, c); }
                    else if (cc < 48) {
#pragma unroll
                        for (int e = 0; e < 4; ++e) { a[e] = sigmoidf_(a[e]); c[e] = sigmoidf_(c[e]); }
                        *(f32x4*)(gates + row * 48 + cc) = a; *(f32x4*)(gates + row * 48 + cc + 4) = c;
                    }
                }
            }
    }
};

DI float wave_sum(float v) {
#pragma unroll
    for (int o = 1; o < 64; o <<= 1) v += __shfl_xor(v, o);
    return v;
}
#define LDS_FENCE() asm volatile("s_waitcnt lgkmcnt(0)" ::: "memory")
struct MapPlain { DI void operator()(int c, int& r, float& s) const { r = c; s = 1.f; } };
struct MapFfnGU { int half; DI void operator()(int c, int& r, float& s) const { r = (c >> 7) * 256 + half * 128 + (c & 127); s = 1.f; } };
struct MapMlaIn { DI void operator()(int c, int& r, float& s) const { s = 1.f;
    if (c < 384) r = 256 + c; else if (c < 640) r = c - 384; else { const int i = c - 640; r = 640 + (i < 16 ? 2 * i : 2 * (i - 16) + 1); } } };
struct MapMlaUq { DI void operator()(int c, int& r, float& s) const { s = 0.10206207261596577f * LOG2E;
    const int h = c / 96, d = c % 96; r = h * 96 + (d < 64 ? d : (d < 80 ? 64 + 2 * (d - 64) : 64 + 2 * (d - 80) + 1)); } };
struct MapMlaUkv { DI void operator()(int c, int& r, float& s) const { s = 1.f; const int h = c >> 7, d = c & 127; r = d < 64 ? h * 64 + d : 1024 + h * 64 + (d - 64); } };
struct MapNsaIn { DI void operator()(int c, int& r, float& s) const { s = 1.f;
    if (c < 1024) { r = c; s = 0.125f * LOG2E; }
    else if (c < 1792) r = c;
    else if (c < 2048) r = 2304 + (c - 1792);
    else if (c < 2304) r = 1792 + (c - 2048);
    else if (c < 2560) r = 2560 + (c - 2304);
    else r = 2048 + (c - 2560); } };
template <class Map>
DI void p0_transpose(const float* W, int K, int N, bf16_t* WT, const float* gain, const Map map, LAS float* scr, int& base, int gw, int NGW, int lane) {
    const int nblk = (N + 31) / 32, nitems = (K / 64) * nblk;
    int first = gw - (base % NGW); if (first < 0) first += NGW;
    base += nitems;
    float cur[32], nxt[32];
    auto loadit = [&](int it, float (&dst)[32]) {
        const int kb = it / nblk, nb = it % nblk, k0 = 64 * kb, c = 32 * nb + (lane & 31);
        const float* p = W + (size_t)(k0 + (lane >> 5)) * N + c;
#pragma unroll
        for (int i = 0; i < 32; ++i) dst[i] = (c < N) ? p[(size_t)(2 * i) * N] : 0.f;
    };
    if (first < nitems) loadit(first, cur);
    for (int it = first; it < nitems; it += NGW) {
        const bool more = it + NGW < nitems;
        if (more) loadit(it + NGW, nxt);
        const int kb = it / nblk, nb = it % nblk, k0 = 64 * kb, n0 = 32 * nb;
#pragma unroll
        for (int i = 0; i < 32; ++i) { const int kk = 2 * i + (lane >> 5); float v = cur[i]; if (gain) v *= gain[k0 + kk]; scr[kk * 33 + (lane & 31)] = v; }
        LDS_FENCE();
        const int ch = lane & 7;
#pragma unroll
        for (int j = 0; j < 4; ++j) { const int n = (lane >> 3) + 8 * j; const int cc = n0 + n;
            if (cc < N) { int r; float sc; map(cc, r, sc); const LAS float* s = scr + (8 * ch) * 33 + n;
                u32x4 o; o.x = pk2(s[0] * sc, s[33] * sc); o.y = pk2(s[66] * sc, s[99] * sc); o.z = pk2(s[132] * sc, s[165] * sc); o.w = pk2(s[198] * sc, s[231] * sc);
                *(u32x4*)(WT + (size_t)r * K + k0 + 8 * ch) = o; } }
        LDS_FENCE();
        if (more) {
#pragma unroll
            for (int i = 0; i < 32; ++i) cur[i] = nxt[i];
        }
    }
}

struct Params {
    const float* in[26];
    float* out;
    unsigned char* ws;
    int ph_lo, ph_hi;
};

DI void p0_prologue(int wv, const Params& P, LAS unsigned char* lds) {
    const int tid = opaque_tid(wv), lane = tid & 63, wave = __builtin_amdgcn_readfirstlane(tid >> 6);
    const int G = gridDim.x, gw = blockIdx.x * 8 + wave, NGW = G * 8;
    LAS float* scr = (LAS float*)(lds + wave * 8448);
    bf16_t* Wb = (bf16_t*)(P.ws + WS_W);
    int base = 0;
    for (int L = 0; L < 4; ++L)
        for (int ab = 0; ab < 2; ++ab) {
            bf16_t* wf = Wb + (size_t)(L * 2 + ab) * FFN_SZ;
            const float* nrm = P.in[ab ? 6 : 1] + L * D;
            const float* wg = P.in[ab ? 7 : 2] + (size_t)L * D * FF; const float* wu = P.in[ab ? 8 : 3] + (size_t)L * D * FF; const float* wd = P.in[ab ? 9 : 4] + (size_t)L * FF * D;
            p0_transpose(wg, D, FF, wf + FFN_WGU, nrm, MapFfnGU{0}, scr, base, gw, NGW, lane);
            p0_transpose(wu, D, FF, wf + FFN_WGU, nrm, MapFfnGU{1}, scr, base, gw, NGW, lane);
            p0_transpose(wd, FF, D, wf + FFN_WD, nullptr, MapPlain{}, scr, base, gw, NGW, lane);
        }
    for (int j = 0; j < 2; ++j) {
        bf16_t* wm = Wb + W_MLA + (size_t)j * MLA_SZ;
        const float* mixn = P.in[5] + (2 * j) * D;
        p0_transpose(P.in[12] + (size_t)j * 1024 * 672, 1024, 672, wm + MLA_WIN, mixn, MapMlaIn{}, scr, base, gw, NGW, lane);
        p0_transpose(P.in[15] + (size_t)j * 384 * 1536, 384, 1536, wm + MLA_WUQ, P.in[13] + j * 384, MapMlaUq{}, scr, base, gw, NGW, lane);
        p0_transpose(P.in[16] + (size_t)j * 256 * 2048, 256, 2048, wm + MLA_WUKV, P.in[14] + j * 256, MapMlaUkv{}, scr, base, gw, NGW, lane);
        p0_transpose(P.in[17] + (size_t)j * 1024 * 1024, 1024, 1024, wm + MLA_WO, nullptr, MapPlain{}, scr, base, gw, NGW, lane);
        bf16_t* wn = Wb + W_NSA + (size_t)j * NSA_SZ;
        const float* mixn2 = P.in[5] + (2 * j + 1) * D;
        p0_transpose(P.in[18] + (size_t)j * 1024 * 2608, 1024, 2608, wn + NSA_WIN, mixn2, MapNsaIn{}, scr, base, gw, NGW, lane);
        p0_transpose(P.in[20] + (size_t)j * 2048 * 128, 2048, 128, wn + NSA_W1K, nullptr, MapPlain{}, scr, base, gw, NGW, lane);
        p0_transpose(P.in[23] + (size_t)j * 2048 * 128, 2048, 128, wn + NSA_W1V, nullptr, MapPlain{}, scr, base, gw, NGW, lane);
        p0_transpose(P.in[21] + (size_t)j * 128 * 64, 128, 64, wn + NSA_W2K, nullptr, MapPlain{}, scr, base, gw, NGW, lane);
        p0_transpose(P.in[24] + (size_t)j * 128 * 64, 128, 64, wn + NSA_W2V, nullptr, MapPlain{}, scr, base, gw, NGW, lane);
        p0_transpose(P.in[25] + (size_t)j * 1024 * 1024, 1024, 1024, wn + NSA_WO, nullptr, MapPlain{}, scr, base, gw, NGW, lane);
    }
    {
        float* rope = (float*)(P.ws + WS_ROPE);
        for (int idx = blockIdx.x * 512 + tid; idx < 32768; idx += G * 512) {
            const int pos = idx >> 4, i = idx & 15;
            const float inv = powf(10000.0f, -(float)i * (2.0f / 32.0f));
            const float ang = (float)pos * inv;
            rope[idx] = cosf(ang); rope[32768 + idx] = sinf(ang);
        }
    }
    {
        float* c1 = (float*)(P.ws + WS_C1);
        for (int o = gw; o < 512; o += NGW) {
            const int j = o >> 8, kv = (o >> 7) & 1, col = o & 127;
            const float* pos = P.in[kv ? 22 : 19] + (size_t)j * 2048; const float* w1 = P.in[kv ? 23 : 20] + (size_t)j * 2048 * 128;
            float s = 0.f;
            for (int i = lane; i < 2048; i += 64) s += pos[i] * w1[(size_t)i * 128 + col];
            s = wave_sum(s);
            if (lane == 0) c1[o] = s;
        }
    }
    {
        const float* x = P.in[0]; bf16_t* hb = (bf16_t*)(P.ws + WS_HB); float* ss = (float*)(P.ws + WS_SS);
        for (int m = gw; m < M; m += 2 * NGW) {
            f32x4 v[2][4];
#pragma unroll
            for (int e = 0; e < 2; ++e)
#pragma unroll
                for (int j = 0; j < 4; ++j) v[e][j] = ((const f32x4*)(x + (size_t)((m + e * NGW) < M ? (m + e * NGW) : m) * D) + lane)[64 * j];
#pragma unroll
            for (int e = 0; e < 2; ++e) {
                if (m + e * NGW >= M) break;
                const size_t mm = (size_t)(m + e * NGW);
                unsigned long long* o8 = (unsigned long long*)(hb + mm * D) + lane;
                float s = 0.f;
#pragma unroll
                for (int j = 0; j < 4; ++j) { const f32x4 t = v[e][j]; s += (t.x * t.x + t.y * t.y) + (t.z * t.z + t.w * t.w);
                    o8[64 * j] = (unsigned long long)pk2(t.x, t.y) | ((unsigned long long)pk2(t.z, t.w) << 32); }
                s = wave_sum(s);
                if (lane < 16) ss[mm * 16 + lane] = (lane == 0) ? s : 0.f;
            }
        }
    }
}

DI void final_norm_phase(int wv, const Params& P) {
    const int tid = opaque_tid(wv), lane = tid & 63, wave = tid >> 6;
    const int gw = blockIdx.x * 8 + wave, NGW = gridDim.x * 8;
    const float* gn = P.in[10]; const bf16_t* hb = (const bf16_t*)(P.ws + WS_HB);
    f32x4 gv[4];
#pragma unroll
    for (int j = 0; j < 4; ++j) gv[j] = ((const f32x4*)gn)[lane + 64 * j];
    for (int m = gw; m < M; m += NGW) {
        const u32x2* hr = (const u32x2*)(hb + (size_t)m * D) + lane; f32x4* orow = (f32x4*)(P.out + (size_t)m * D) + lane;
        f32x4 v[4]; float s = 0.f;
#pragma unroll
        for (int j = 0; j < 4; ++j) { const u32x2 w = hr[64 * j];
            v[j].x = __uint_as_float(w.x << 16); v[j].y = __uint_as_float(w.x & 0xffff0000u); v[j].z = __uint_as_float(w.y << 16); v[j].w = __uint_as_float(w.y & 0xffff0000u);
            s += (v[j].x * v[j].x + v[j].y * v[j].y) + (v[j].z * v[j].z + v[j].w * v[j].w); }
        const float rs = rsqrtf(wave_sum(s) * (1.f / 1024.f) + EPS);
#pragma unroll
        for (int j = 0; j < 4; ++j) orow[64 * j] = v[j] * rs * gv[j];
    }
}

DI f32x16 mfma32(bf16x8 a, bf16x8 b, f32x16 c) { return __builtin_amdgcn_mfma_f32_32x32x16_bf16(a, b, c, 0, 0, 0); }
DI int crow(int i, int hh) { return (i & 3) + 8 * (i >> 2) + 4 * hh; }
DI f32x16 zero16() { f32x16 z; for (int i = 0; i < 16; ++i) z[i] = 0.f; return z; }
template <int S_>
DI bf16x8 pack8(const f32x16& x) {
    u32x4 p; p.x = pk2(x[8 * S_], x[8 * S_ + 1]); p.y = pk2(x[8 * S_ + 2], x[8 * S_ + 3]); p.z = pk2(x[8 * S_ + 4], x[8 * S_ + 5]); p.w = pk2(x[8 * S_ + 6], x[8 * S_ + 7]);
    return __builtin_bit_cast(bf16x8, p);
}
DI f32x16 splat16(float v) { f32x16 z; for (int i = 0; i < 16; ++i) z[i] = v; return z; }
DI bf16x8 ref_frag(float negm, float extra, int hh) {
    const unsigned hi = pk2(negm, 0.f) & 0xffffu;
    const unsigned lo = pk2(negm - __uint_as_float(hi << 16), 0.f) & 0xffffu;
    const unsigned ex = pk2(extra, 0.f) & 0xffffu;
    u32x4 v; v.x = hh ? 0u : (hi | (lo << 16)); v.y = hh ? 0u : ex; v.z = 0u; v.w = 0u;
    return __builtin_bit_cast(bf16x8, v);
}
DI bf16x8 ones_frag(int hh) { u32x4 v; v.x = hh ? 0u : 0x3F803F80u; v.y = hh ? 0u : 0x00003F80u; v.z = 0u; v.w = 0u; return __builtin_bit_cast(bf16x8, v); }
template <int NKS>
DI void qk_tile(const LAS unsigned char* kt, int kstride, const bf16x8 (&qf)[NKS], f32x16 (&s)[2], int r, int hh, const bf16x8 rf) {
    const bf16x8 of = ones_frag(hh);
#pragma unroll
    for (int t = 0; t < 2; ++t) {
        bf16x8 kf[NKS];
#pragma unroll
        for (int ks = 0; ks < NKS; ++ks) kf[ks] = *(const LAS bf16x8*)(kt + (32 * t + r) * kstride + 32 * ks + 16 * hh);
        __builtin_amdgcn_sched_barrier(0);
        s[t] = zero16();
#pragma unroll
        for (int ks = 0; ks < NKS; ++ks) s[t] = mfma32(kf[ks], qf[ks], s[t]);
        s[t] = mfma32(of, rf, s[t]);
    }
}
DI void pv_sub(const LAS unsigned char* vt, int vstride, int koff_bytes, const f32x16& p, f32x16 (&o)[2], int r, int hh) {
    const bf16x8 pf0 = pack8<0>(p), pf1 = pack8<1>(p);
#pragma unroll
    for (int st = 0; st < 2; ++st) {
        u32x2 lo[2], hi[2];
#pragma unroll
        for (int u = 0; u < 2; ++u) {
            const LAS unsigned char* a = vt + (32 * u + r) * vstride + koff_bytes + 32 * st + 8 * hh;
            lo[u] = *(const LAS u32x2*)a; hi[u] = *(const LAS u32x2*)(a + 16);
        }
        __builtin_amdgcn_sched_barrier(0);
#pragma unroll
        for (int u = 0; u < 2; ++u) { u32x4 v; v.x = lo[u].x; v.y = lo[u].y; v.z = hi[u].x; v.w = hi[u].y; o[u] = mfma32(__builtin_bit_cast(bf16x8, v), st ? pf1 : pf0, o[u]); }
    }
}
DI void softmax_lazy(f32x16 (&s)[2], float& m, float& l, f32x16 (&o)[2], int hh) {
    float mx = s[0][0];
#pragma unroll
    for (int i = 1; i < 16; ++i) mx = fmaxf(mx, s[0][i]);
#pragma unroll
    for (int i = 0; i < 16; ++i) mx = fmaxf(mx, s[1][i]);
    mx = fmaxf(mx, __shfl_xor(mx, 32));
    const bool live = mx > -1e29f;
    const bool slow = live && (mx > 32.f || (mx < -32.f && l == 0.f));
    if (__ballot(slow) != 0ull) {
        const float shift = (live && (mx > 0.f || l == 0.f)) ? mx : 0.f;
        const float alpha = (l == 0.f) ? 0.f : fexp2(-shift);
        const bf16x8 of = ones_frag(hh), sf = ref_frag(-shift, 0.f, hh);
        s[0] = mfma32(of, sf, s[0]); s[1] = mfma32(of, sf, s[1]);
        l *= alpha; m += shift;
        o[0] *= alpha; o[1] *= alpha;
    }
    float sum = 0.f;
#pragma unroll
    for (int t = 0; t < 2; ++t)
#pragma unroll
        for (int i = 0; i < 16; ++i) { s[t][i] = fexp2(s[t][i]); sum += s[t][i]; }
    sum += __shfl_xor(sum, 32);
    l += sum;
}
DI void softmax_lazy1(f32x16& s, float& m, float& l, f32x16 (&o)[2], int hh) {
    float mx = s[0];
#pragma unroll
    for (int i = 1; i < 16; ++i) mx = fmaxf(mx, s[i]);
    mx = fmaxf(mx, __shfl_xor(mx, 32));
    const bool live = mx > -1e29f;
    const bool slow = live && (mx > 32.f || (mx < -32.f && l == 0.f));
    if (__ballot(slow) != 0ull) {
        const float shift = (live && (mx > 0.f || l == 0.f)) ? mx : 0.f;
        const float alpha = (l == 0.f) ? 0.f : fexp2(-shift);
        s = mfma32(ones_frag(hh), ref_frag(-shift, 0.f, hh), s);
        l *= alpha; m += shift;
        o[0] *= alpha; o[1] *= alpha;
    }
    float sum = 0.f;
#pragma unroll
    for (int i = 0; i < 16; ++i) { s[i] = fexp2(s[i]); sum += s[i]; }
    sum += __shfl_xor(sum, 32);
    l += sum;
}
DI void lds_store16_as2x8(LAS unsigned char* p, u32x4 v) { u32x2 a, b; a.x = v.x; a.y = v.y; b.x = v.z; b.y = v.w; *(LAS u32x2*)p = a; *(LAS u32x2*)(p + 8) = b; }
DI void store_ot(const f32x16 (&o)[2], float sc, bf16_t* dst  , int hh) {
#pragma unroll
    for (int u = 0; u < 2; ++u)
#pragma unroll
        for (int gq = 0; gq < 4; ++gq) {
            u32x2 w; w.x = pk2(o[u][4 * gq] * sc, o[u][4 * gq + 1] * sc); w.y = pk2(o[u][4 * gq + 2] * sc, o[u][4 * gq + 3] * sc);
            *(u32x2*)(dst + 32 * u + 8 * gq + 4 * hh) = w;
        }
}

DI void pv_sub2(const LAS unsigned char* vt, int vstride, int koff_bytes, const f32x16& p0, const f32x16& p1, f32x16 (&o0)[2], f32x16 (&o1)[2], int r, int hh) {
#pragma unroll
    for (int st = 0; st < 2; ++st) {
        u32x2 lo[2], hi[2];
#pragma unroll
        for (int u = 0; u < 2; ++u) {
            const LAS unsigned char* a = vt + (32 * u + r) * vstride + koff_bytes + 32 * st + 8 * hh;
            lo[u] = *(const LAS u32x2*)a; hi[u] = *(const LAS u32x2*)(a + 16);
        }
        const bf16x8 pf0 = st ? pack8<1>(p0) : pack8<0>(p0), pf1 = st ? pack8<1>(p1) : pack8<0>(p1);
        __builtin_amdgcn_sched_barrier(0);
#pragma unroll
        for (int u = 0; u < 2; ++u) { u32x4 v; v.x = lo[u].x; v.y = lo[u].y; v.z = hi[u].x; v.w = hi[u].y; const bf16x8 vf = __builtin_bit_cast(bf16x8, v);
            o0[u] = mfma32(vf, pf0, o0[u]); o1[u] = mfma32(vf, pf1, o1[u]); }
    }
}
template <int NKS>
DI void qk_tile2(const LAS unsigned char* kt, int kstride, const bf16x8 (&q0)[NKS], const bf16x8 (&q1)[NKS], f32x16 (&s0)[2], f32x16 (&s1)[2], int r, int hh) {
#pragma unroll
    for (int t = 0; t < 2; ++t) {
        s0[t] = zero16(); s1[t] = zero16();
#pragma unroll
        for (int ks = 0; ks < NKS; ++ks) {
            const bf16x8 kf = *(const LAS bf16x8*)(kt + (32 * t + r) * kstride + 32 * ks + 16 * hh);
            s0[t] = mfma32(kf, q0[ks], s0[t]); s1[t] = mfma32(kf, q1[ks], s1[t]);
        }
    }
}
DI void mla_qblock(int wv, int w, LAS unsigned char* lds, const bf16_t* Q, const bf16_t* KN, const bf16_t* KR, const bf16_t* VT, bf16_t* O, size_t tok0, int h, int qb) {
    constexpr int KS = 208, VS = 136, VOFF = 64 * KS, TILE = VOFF + 64 * VS;
    const int tid = opaque_tid(wv), lane = tid & 63, r = lane & 31, hh = lane >> 5;
    const int R0 = 512 * qb + 64 * w, tq0 = R0 + r, tq1 = tq0 + 32;
    bf16x8 q0[6], q1[6];
#pragma unroll
    for (int ks = 0; ks < 6; ++ks) { q0[ks] = *(const bf16x8*)(Q + (tok0 + tq0) * 1536 + h * 96 + 16 * ks + 8 * hh); q1[ks] = *(const bf16x8*)(Q + (tok0 + tq1) * 1536 + h * 96 + 16 * ks + 8 * hh); }
    float m0 = 0.f, l0 = 0.f, m1 = 0.f, l1 = 0.f; f32x16 o0[2] = {zero16(), zero16()}, o1[2] = {zero16(), zero16()};
    const int nt = 8 * qb + 8, nfull = 8 * qb;
    u32x4 rk, rr, rv;
    const bf16_t* gk = KN + ((tok0 >> 11) * 16 + h) * (size_t)(2048 * 64) + (size_t)tid * 8;
    const bf16_t* gr = KR + tok0 * 32 + (size_t)tid * 8;
    const bf16_t* gv = VT + ((tok0 >> 11) * 1024 + h * 64 + (tid >> 3)) * (size_t)VPITCH + (tid & 7) * 8;
    const bool lo256 = tid < 256;
#define MLA_GLOAD(t) do { const size_t ko = (size_t)(64 * (t)); rk = *(const u32x4*)(gk + ko * 64); if (lo256) rr = *(const u32x4*)(gr + ko * 32); rv = *(const u32x4*)(gv + ko); } while (0)
#define MLA_LSTORE(buf) do { LAS unsigned char* kb_ = lds + (buf) * TILE; *(LAS u32x4*)(kb_ + (tid >> 3) * KS + (tid & 7) * 16) = rk; \
        if (lo256) *(LAS u32x4*)(kb_ + (tid >> 2) * KS + 128 + (tid & 3) * 16) = rr; lds_store16_as2x8(kb_ + VOFF + (tid >> 3) * VS + (tid & 7) * 16, rv); } while (0)
    MLA_GLOAD(0); MLA_LSTORE(0); if (nt > 1) MLA_GLOAD(1); __syncthreads();
#define MLA_QK1(tt) do { bf16x8 kf_[6]; _Pragma("unroll") for (int ks = 0; ks < 6; ++ks) kf_[ks] = *(const LAS bf16x8*)(kb + (32 * (tt) + r) * KS + 32 * ks + 16 * hh); \
        __builtin_amdgcn_sched_barrier(0); s0 = zero16(); s1 = zero16(); \
        _Pragma("unroll") for (int ks = 0; ks < 6; ++ks) { s0 = mfma32(kf_[ks], q0[ks], s0); s1 = mfma32(kf_[ks], q1[ks], s1); } \
        { const bf16x8 of_ = ones_frag(hh); s0 = mfma32(of_, ref_frag(-m0, 0.f, hh), s0); s1 = mfma32(of_, ref_frag(-m1, 0.f, hh), s1); } } while (0)
    int bi = 0;
    for (int t = 0; t < nfull; ++t) {
        const int bn = bi == 2 ? 0 : bi + 1;
        MLA_LSTORE(bn);
        if (t + 2 < nt) MLA_GLOAD(t + 2);
        const LAS unsigned char* kb = lds + bi * TILE;
#pragma nounroll
        for (int tt = 0; tt < 2; ++tt) {
            f32x16 s0, s1;
            MLA_QK1(tt);
            softmax_lazy1(s0, m0, l0, o0, hh); softmax_lazy1(s1, m1, l1, o1, hh);
            pv_sub2(kb + VOFF, VS, 64 * tt, s0, s1, o0, o1, r, hh);
        }
        __syncthreads();
        bi = bn;
    }
#pragma nounroll
    for (int t = nfull; t < nt; ++t) {
        const int bn = bi == 2 ? 0 : bi + 1;
        if (t + 1 < nt) MLA_LSTORE(bn);
        if (t + 2 < nt) MLA_GLOAD(t + 2);
        const int k0 = 64 * t;
        if (k0 <= R0 + 63) {
            const LAS unsigned char* kb = lds + bi * TILE;
#pragma nounroll
            for (int tt = 0; tt < 2; ++tt) {
                f32x16 s0, s1;
                MLA_QK1(tt);
#pragma unroll
                for (int i = 0; i < 16; ++i) { const int key = k0 + 32 * tt + crow(i, hh); if (key > tq0) s0[i] = NEGF; if (key > tq1) s1[i] = NEGF; }
                softmax_lazy1(s0, m0, l0, o0, hh); softmax_lazy1(s1, m1, l1, o1, hh);
                pv_sub2(kb + VOFF, VS, 64 * tt, s0, s1, o0, o1, r, hh);
            }
        }
        __syncthreads();
        bi = bn;
    }
#undef MLA_QK1
    store_ot(o0, frcp(l0), O + (tok0 + tq0) * 1024 + h * 64, hh);
    store_ot(o1, frcp(l1), O + (tok0 + tq1) * 1024 + h * 64, hh);
#undef MLA_GLOAD
#undef MLA_LSTORE
}
template <int SKIP>
DI void mla_attn_phase(int wv, LAS unsigned char* lds, const bf16_t* Q, const bf16_t* KN, const bf16_t* KR, const bf16_t* VT, bf16_t* O) {
    const int w = __builtin_amdgcn_readfirstlane(opaque_tid(wv) >> 6);
    const int bx = blockIdx.x, nG = gridDim.x;
    const int vcu = (nG == 256) ? (bx & 7) * 32 + (bx >> 3) : bx;
    for (int grp = vcu >> 2; grp < 64; grp += (nG + 3) >> 2) {
        const int k = vcu & 3;
#pragma nounroll
        for (int it = 0; it < 4; ++it) {
            const int pair = grp * 4 + it, qb = (it & 1) ? 3 - k : k;
            mla_qblock(wv, w, lds, Q, KN, KR, VT, O, (size_t)(pair >> 4) * SEQ, pair & 15, qb);
        }
    }
}

DI void nsa_compress_phase(int wv, LAS unsigned char* lds, const bf16_t* slab  , const bf16_t* wn  , const float* c1  , bf16_t* KCMP, bf16_t* VCMPT) {
    constexpr int HS = 272;
    const int tid = opaque_tid(wv), lane = tid & 63, w = __builtin_amdgcn_readfirstlane(tid >> 6), r = lane & 31, hh = lane >> 5;
    for (int item = blockIdx.x; item < 256; item += gridDim.x) {
        const int b = item >> 4, g = (item >> 2) & 3, kv = (item >> 1) & 1, nh = item & 1;
        const bf16_t* src = slab + (size_t)kv * SLAB_EL + (size_t)(b * 4 + g) * 2048 * 64;
        const bf16_t* w1t = wn + (kv ? NSA_W1V : NSA_W1K); const bf16_t* w2t = wn + (kv ? NSA_W2V : NSA_W2K);
        {
            const int rh = w >> 2, cq = w & 3;
            int n = 64 * nh + 32 * rh + r; if (n > 126) n = 126;
            const bf16_t* ap = src + (size_t)n * 1024 + 8 * hh;
            const bf16_t* bp = w1t + (size_t)(32 * cq + r) * 2048 + 8 * hh;
            f32x16 acc = zero16();
#pragma unroll 8
            for (int ks = 0; ks < 128; ++ks) {
                const bf16x8 xa = *(const bf16x8*)(ap + 16 * ks), wb = *(const bf16x8*)(bp + 16 * ks);
                acc = mfma32(wb, xa, acc);
            }
            const float* cb = c1 + kv * 128;
#pragma unroll
            for (int gq = 0; gq < 4; ++gq) {
                float v[4];
#pragma unroll
                for (int e = 0; e < 4; ++e) { const int j = 32 * cq + 8 * gq + 4 * hh + e; const float x = acc[4 * gq + e] + cb[j];
                    const float u2 = 2.f * 0.7978845608028654f * (x + 0.044715f * x * x * x); v[e] = x * sigmoidf_(u2); }
                u32x2 wv; wv.x = pk2(v[0], v[1]); wv.y = pk2(v[2], v[3]);
                *(LAS u32x2*)(lds + (32 * rh + r) * HS + (32 * cq + 8 * gq + 4 * hh) * 2) = wv;
            }
        }
        __syncthreads();
        if (w < 4) {
            const int rh2 = w >> 1, dq = w & 1;
            f32x16 acc = zero16();
#pragma unroll
            for (int ks = 0; ks < 8; ++ks) {
                const bf16x8 hf = *(const LAS bf16x8*)(lds + (32 * rh2 + r) * HS + (16 * ks + 8 * hh) * 2);
                const bf16x8 wf = *(const bf16x8*)(w2t + (size_t)(32 * dq + r) * 128 + 16 * ks + 8 * hh);
                if (kv == 0) acc = mfma32(wf, hf, acc);
                else acc = mfma32(hf, wf, acc);
            }
            if (kv == 0) {
                bf16_t* dst = KCMP + ((size_t)(b * 4 + g) * 128 + 64 * nh + 32 * rh2 + r) * 64 + 32 * dq;
#pragma unroll
                for (int gq = 0; gq < 4; ++gq) { u32x2 wv; wv.x = pk2(acc[4 * gq], acc[4 * gq + 1]); wv.y = pk2(acc[4 * gq + 2], acc[4 * gq + 3]); *(u32x2*)(dst + 8 * gq + 4 * hh) = wv; }
            } else {
                bf16_t* dst = VCMPT + ((size_t)(b * 4 + g) * 64 + 32 * dq + r) * 128 + 64 * nh + 32 * rh2;
#pragma unroll
                for (int gq = 0; gq < 4; ++gq) { u32x2 wv; wv.x = pk2(acc[4 * gq], acc[4 * gq + 1]); wv.y = pk2(acc[4 * gq + 2], acc[4 * gq + 3]); *(u32x2*)(dst + 8 * gq + 4 * hh) = wv; }
            }
        }
        __syncthreads();
    }
}

DI int t5_bucket(int n) {
    if (n < 16) return n;
    int v = 16 + (int)(logf((float)n / 16.f) / 2.0794415416798357f * 16.f);
    return v < 31 ? v : 31;
}
DI void nsa_attn_phase(int wv, LAS unsigned char* lds, const bf16_t* Q, const bf16_t* slab, const bf16_t* VT2, const float* gates, const bf16_t* KCMP, const bf16_t* VCMPT,
                       const float* rel_bias, bf16_t* O) {
    constexpr int KCS = 144, VCS = 264, KS = 144, VS = 136;
    constexpr int OFF_KC = 0, OFF_VC = 128 * KCS, OFF_BUF = OFF_VC + 64 * VCS, VOFF = 64 * KS, TILE = VOFF + 64 * VS, BUF = 2 * TILE;
    constexpr int OFF_IMP = OFF_BUF  , OFF_SC = OFF_IMP + 4 * 64 * 33 * 4;
    constexpr int OFF_SEL = OFF_BUF + 2 * BUF, OFF_LUT = OFF_SEL + 256;
    static_assert(OFF_SC + 64 * 33 * 4 <= OFF_SEL && OFF_LUT + 2048 <= LDS_GEMM, "nsa lds");
    const int tid0 = opaque_tid(wv), w = __builtin_amdgcn_readfirstlane(tid0 >> 6);
    const int rhead = w & 3, half = w >> 2;
    LAS float* impw = (LAS float*)(lds + OFF_IMP); LAS float* score = (LAS float*)(lds + OFF_SC); LAS unsigned* selm = (LAS unsigned*)(lds + OFF_SEL); LAS float* lut = (LAS float*)(lds + OFF_LUT);
#if PROBE_VARIANT == 3 || PROBE_VARIANT == 4
#pragma nounroll
    for (int nrep = 0; nrep < 2; ++nrep)
#else
    constexpr int nrep = 1;
#endif
    for (int item0 = blockIdx.x; item0 < 256; item0 += gridDim.x) {
        const int item = (gridDim.x == 256) ? (item0 & 7) * 32 + (item0 >> 3) : item0;
        const int b = item >> 4, g = (item >> 2) & 3, qtr = item & 3;
        const int head = g * 4 + rhead;
        const size_t bg = (size_t)(b * 4 + g);
        int tid = opaque_tid(wv), lane = tid & 63;
        __syncthreads();
#pragma unroll
        for (int e = 0; e < 2; ++e) { const int pc = tid + 512 * e;
            const u32x4 v = *(const u32x4*)(KCMP + bg * 128 * 64 + (size_t)pc * 8); *(LAS u32x4*)(lds + OFF_KC + (pc >> 3) * KCS + (pc & 7) * 16) = v;
            const u32x4 v2 = *(const u32x4*)(VCMPT + bg * 64 * 128 + (size_t)pc * 8); lds_store16_as2x8(lds + OFF_VC + (pc >> 4) * VCS + (pc & 15) * 16, v2); }
        lut[tid] = rel_bias[t5_bucket(tid & 127) * 16 + g * 4 + (tid >> 7)] * LOG2E;
        __syncthreads();
        const LAS float* mylut = lut + rhead * 128;
#pragma nounroll
        for (int qi = 0; qi < 8; ++qi) {
            tid = opaque_tid(wv); lane = tid & 63; const int r = lane & 31, hh = lane >> 5;
            const int qblk = 4 * qi + ((qi & 1) ? 3 - qtr : qtr), T0 = 64 * qblk, TW = T0 + 32 * half;
            const int tq = TW + r; const size_t token = (size_t)b * SEQ + tq;
            const float c31 = mylut[127];
            bf16x8 qf[4];
#pragma unroll
            for (int ks = 0; ks < 4; ++ks) qf[ks] = *(const bf16x8*)(Q + token * 1024 + head * 64 + 16 * ks + 8 * hh);
            const float g0 = gates[token * 48 + head * 3], g1 = gates[token * 48 + head * 3 + 1], g2 = gates[token * 48 + head * 3 + 2];
            f32x16 out[2] = {zero16(), zero16()};
            const bool need_rank = qblk >= 16;
            {
                const int nsub = (TW >> 9) + 1;
                f32x16 s4[4];
                float mx = NEGF;
#pragma unroll
                for (int t = 0; t < 4; ++t) {
                    if (t < nsub) {
                        const bool farc = TW - (16 * (32 * t + 31) + 31) >= 127;
                        s4[t] = splat16(farc ? c31 : 0.f);
                        bf16x8 kfc[4];
#pragma unroll
                        for (int ks = 0; ks < 4; ++ks) kfc[ks] = *(const LAS bf16x8*)(lds + OFF_KC + (32 * t + r) * KCS + 32 * ks + 16 * hh);
#pragma unroll
                        for (int ks = 0; ks < 4; ++ks) s4[t] = mfma32(kfc[ks], qf[ks], s4[t]);
                        if (!farc) {
                            const int d0 = tq - 31 - 16 * (32 * t + 4 * hh);
#pragma unroll
                            for (int i = 0; i < 16; ++i) {
                                const int dist = d0 - 16 * ((i & 3) + 8 * (i >> 2));
                                const float bias = mylut[dist < 0 ? 0 : (dist > 127 ? 127 : dist)];
                                s4[t][i] = dist >= 0 ? s4[t][i] + bias : NEGF;
                            }
                        }
#pragma unroll
                        for (int i = 0; i < 16; ++i) mx = fmaxf(mx, s4[t][i]);
                    }
                    __builtin_amdgcn_sched_barrier(0);
                }
                mx = fmaxf(mx, __shfl_xor(mx, 32));
                const float live = mx > -1e29f ? 1.f : 0.f;
                float sum = 0.f;
#pragma unroll
                for (int t = 0; t < 4; ++t) {
                    if (t < nsub) {
#pragma unroll
                        for (int i = 0; i < 16; ++i) { const float p = fexp2(s4[t][i] - mx) * live; s4[t][i] = p; sum += p; }
                    } else s4[t] = zero16();
                }
                sum += __shfl_xor(sum, 32);
                const float inv = sum > 0.f ? 1.f / sum : 0.f;
#pragma unroll
                for (int t = 0; t < 4; ++t) s4[t] *= inv;
                if (need_rank) {
                    float xprev = 0.f;
                    LAS float* irow = impw + (rhead * 64 + 32 * half + r) * 33;
#pragma unroll
                    for (int t = 0; t < 4; ++t)
#pragma unroll
                        for (int gq = 0; gq < 4; ++gq) {
                            const float a = (s4[t][4 * gq] + s4[t][4 * gq + 1]) + (s4[t][4 * gq + 2] + 0.5f * s4[t][4 * gq + 3]);
                            const float bc = 0.5f * s4[t][4 * gq + 3];
                            const float xc = __shfl_xor(bc, 32);
                            const float cin = hh ? xc : xprev; xprev = xc;
                            irow[8 * t + 2 * gq + hh] = a + cin;
                        }
                }
#pragma unroll
                for (int t = 0; t < 4; ++t) if (t < nsub) { s4[t] *= g0; pv_sub(lds + OFF_VC, VCS, 64 * t, s4[t], out, r, hh); }
            }
            const unsigned causal = (qblk >= 31) ? 0xffffffffu : ((2u << qblk) - 1u);
            unsigned mysel = causal, uni = causal;
            if (need_rank) {
                __syncthreads();
#pragma unroll
                for (int e = 0; e < 4; ++e) { const int idx = tid + 512 * e, tok = idx >> 5, j = idx & 31;
                    const float v = (impw[(0 * 64 + tok) * 33 + j] + impw[(1 * 64 + tok) * 33 + j]) + (impw[(2 * 64 + tok) * 33 + j] + impw[(3 * 64 + tok) * 33 + j]);
                    const bool forced = (j == 0) || (j == qblk) || (j == qblk - 1);
                    score[tok * 33 + j] = forced ? 1e6f : (j <= qblk ? v : -1e6f); }
                if (tid < 64) selm[tid] = 0u;
                __syncthreads();
#pragma nounroll
                for (int e = 0; e < 4; ++e) { const int idx = tid + 512 * e, tok = idx >> 5, j = idx & 31;
                    const float my = score[tok * 33 + j]; int rank = 0;
#pragma unroll 8
                    for (int j2 = 0; j2 < 32; ++j2) { const float o2 = score[tok * 33 + j2]; rank += (o2 > my || (o2 == my && j2 < j)) ? 1 : 0; }
                    if (rank < 16) atomicOr((unsigned*)(selm + tok), 1u << j); }
                __syncthreads();
                mysel = selm[32 * half + r] & causal;
                uni = selm[lane];
#pragma unroll
                for (int o = 1; o < 64; o <<= 1) uni |= __shfl_xor(uni, o);
                uni &= causal;
            }
#pragma nounroll
            for (int br = (PROBE_VARIANT == 4 && nrep == 0) ? 2 : 0; br < 2; ++br) {
                const bf16_t* Ksrc = slab + (size_t)(br ? 3 : 2) * SLAB_EL + bg * 2048 * 64;
                const bf16_t* Vsrc = VT2 + ((size_t)b * 512 + (br ? 256 : 0) + g * 64) * VPITCH;
                unsigned tiles;
                if (br == 0) tiles = uni; else { const int jlo = qblk - 8 < 0 ? 0 : qblk - 8; tiles = causal & ~((1u << jlo) - 1u); }
                float m = 0.f, l = 0.f; f32x16 o[2] = {zero16(), zero16()};
                u32x4 rk, rv;
                auto gload = [&](int j) {
                    rk = *(const u32x4*)(Ksrc + (size_t)j * 64 * 64 + (size_t)tid * 8);
                    rv = *(const u32x4*)(Vsrc + (size_t)(tid >> 3) * VPITCH + 64 * j + (tid & 7) * 8);
                };
                auto lstore = [&](int buf) {
                    LAS unsigned char* kb = lds + OFF_BUF + buf * TILE;
                    *(LAS u32x4*)(kb + (tid >> 3) * KS + (tid & 7) * 16) = rk;
                    lds_store16_as2x8(kb + VOFF + (tid >> 3) * VS + (tid & 7) * 16, rv);
                };
                auto process = [&](const LAS unsigned char* kb, int j) {
                    const int k0 = 64 * j;
                    const bool selbit = (br == 0) ? (((mysel >> j) & 1u) != 0u) : true;
                    if (br == 0 && __ballot(selbit) == 0ull) return;
                    const bool far = (TW - (k0 + 63) >= 127) && (br == 0 || (TW + 31 - k0 < 512));
                    f32x16 s[2];
                    qk_tile<4>(kb, KS, qf, s, r, hh, ref_frag(-m, far ? (selbit ? c31 : NEGF) : 0.f, hh));
                    if (!far) {
                        const int d0 = tq - k0 - 4 * hh;
#pragma unroll
                        for (int t = 0; t < 2; ++t)
#pragma unroll
                            for (int i = 0; i < 16; ++i) {
                                const int dist = d0 - (32 * t + (i & 3) + 8 * (i >> 2));
                                const float bias = mylut[dist < 0 ? 0 : (dist > 127 ? 127 : dist)];
                                const bool valid = selbit && dist >= 0 && (br == 0 || dist < 512);
                                s[t][i] = valid ? s[t][i] + bias : NEGF;
                            }
                    }
                    softmax_lazy(s, m, l, o, hh);
                    pv_sub(kb + VOFF, VS, 0, s[0], o, r, hh);
                    pv_sub(kb + VOFF, VS, 64, s[1], o, r, hh);
                };
                int j = __builtin_ctz(tiles); tiles &= tiles - 1;
                gload(j); lstore(0);
                int jn = -1; if (tiles) { jn = __builtin_ctz(tiles); tiles &= tiles - 1; gload(jn); }
                __syncthreads();
                int bi = 0;
                for (;;) {
                    const int bn = bi == 2 ? 0 : bi + 1;
                    if (jn >= 0) lstore(bn);
                    int jnn = -1; if (tiles) { jnn = __builtin_ctz(tiles); tiles &= tiles - 1; gload(jnn); }
                    process(lds + OFF_BUF + bi * TILE, j);
                    __syncthreads();
                    if (jn < 0) break;
                    j = jn; jn = jnn; bi = bn;
                }
                const float sc = (br ? g2 : g1) * frcp(l);
                out[0] += o[0] * sc; out[1] += o[1] * sc;
            }
            {
                const int l2 = opaque_tid(wv) & 63, tq2 = TW + (l2 & 31);
                store_ot(out, 1.f, O + ((size_t)b * SEQ + tq2) * 1024 + head * 64, l2 >> 5);
            }
        }
    }
}

#define XB_TMO      128
#define XB_XCNT(j)  (256  + 64 * (j))
#define XB_XSUB(j)  (1280 + 64 * (j))
#define XB_XGEN(j)  (2304 + 64 * (j))
#define XB_TOP      3328
#define XB_TOPGEN   3392
#define XCD_BAR_WORDS 3456
#define XB_SPIN_CAP (1u << 18)
DI unsigned xb_ld(unsigned* p)              { return __hip_atomic_load(p, __ATOMIC_RELAXED, __HIP_MEMORY_SCOPE_AGENT); }
DI unsigned xb_add(unsigned* p, unsigned v) { return __hip_atomic_fetch_add(p, v, __ATOMIC_RELAXED, __HIP_MEMORY_SCOPE_AGENT); }
DI unsigned xb_xcc_id() { return (unsigned)__builtin_amdgcn_s_getreg((3 << 11) | 20) & 0xFu; }
#define XB_SPIN(cond, bar) do { unsigned _sp = 0; while (cond) { __builtin_amdgcn_s_sleep(1); \
    if ((++_sp & 255u) == 0u) { if (xb_ld(&(bar)[XB_TMO])) break; if (_sp > XB_SPIN_CAP) { atomicAdd(&(bar)[XB_TMO], 1u); break; } } } } while (0)
DI void xcd_barrier_complete(unsigned* bar, unsigned x, unsigned& nloc, unsigned& nx) {
    const unsigned G = gridDim.x;
    unsigned sum, cnt, mine, sp = 0u;
    for (;;) {
        sum = 0u; cnt = 0u; mine = 0u;
#pragma unroll
        for (unsigned j = 0; j < 16; ++j) { const unsigned c = xb_ld(&bar[XB_XCNT(j)]); sum += c; cnt += (c > 0u) ? 1u : 0u; mine = (j == x) ? c : mine; }
        if (sum == G) break;
        __builtin_amdgcn_s_sleep(1);
        if ((++sp & 255u) == 0u) { if (xb_ld(&bar[XB_TMO])) break; if (sp > XB_SPIN_CAP) { atomicAdd(&bar[XB_TMO], 1u); break; } }
    }
    nloc = mine > 0u ? mine : 1u; nx = cnt > 0u ? cnt : 1u;
}
DI void xcd_barrier(int wv, unsigned* bar, volatile LAS unsigned* st) {
    asm volatile("s_waitcnt vmcnt(0)" ::: "memory");
    __syncthreads();
    if (opaque_tid(wv) == 0) {
        const unsigned x = xb_xcc_id();
        __builtin_amdgcn_s_waitcnt(0);
        unsigned nloc = st[0], nx = st[1];
        if (nloc == 0u) { xcd_barrier_complete(bar, x, nloc, nx); st[0] = nloc; st[1] = nx; }
        const unsigned old = xb_add(&bar[XB_XSUB(x)], 1u);
        const unsigned gen = old / nloc;
        if (old + 1u == (gen + 1u) * nloc) {
            __builtin_amdgcn_fence(__ATOMIC_RELEASE, "agent");
            asm volatile("s_waitcnt vmcnt(0)" ::: "memory");
            const unsigned og = xb_add(&bar[XB_TOP], 1u);
            const unsigned tg = og / nx;
            if (og + 1u == (tg + 1u) * nx) xb_add(&bar[XB_TOPGEN], 1u);
            else XB_SPIN(xb_ld(&bar[XB_TOPGEN]) == tg, bar);
            __builtin_amdgcn_fence(__ATOMIC_ACQUIRE, "agent");
            xb_add(&bar[XB_XGEN(x)], 1u);
            asm volatile("s_waitcnt vmcnt(0)" ::: "memory");
        } else {
            XB_SPIN(xb_ld(&bar[XB_XGEN(x)]) == gen, bar);
            __builtin_amdgcn_fence(__ATOMIC_ACQUIRE, "agent");
            asm volatile("s_waitcnt vmcnt(0)" ::: "memory");
        }
    }
    __syncthreads();
}

DI unsigned char* launder_ptr(unsigned char* p) { asm volatile("" : "+s"(p)); return p; }
__global__ void __launch_bounds__(512, 2) mega_fwd(Params P) {
    extern __shared__ __attribute__((aligned(16))) unsigned char lds_raw[];
    LAS unsigned char* lds = (LAS unsigned char*)lds_raw;
    cg::grid_group grid = cg::this_grid();
    const int wv = __builtin_amdgcn_readfirstlane((int)(threadIdx.x >> 6));
    const int lo = P.ph_lo, hi = P.ph_hi;
    int ph = 0;
    {
        volatile LAS unsigned* st = (volatile LAS unsigned*)(lds + LDS_GEMM);
        if (threadIdx.x == 0) { st[0] = 0u; st[1] = 0u; (void)xb_add(&((unsigned*)(P.ws + WS_BAR))[XB_XCNT(xb_xcc_id())], 1u); }
        __syncthreads();
    }
#define GRID_BAR() xcd_barrier(wv, (unsigned*)(launder_ptr(P.ws) + WS_BAR), (volatile LAS unsigned*)(lds + LDS_GEMM))
#define PH_BEGIN_C(cls) if (ph >= lo && ph < hi) { for (int _rep = 0; _rep < (((PROBE_MASK >> (cls)) & 1) ? 2 : 1); ++_rep) { if (_rep) GRID_BAR(); unsigned char* ws = launder_ptr(P.ws); bf16_t* Wb = (bf16_t*)(ws + WS_W); bf16_t* HB = (bf16_t*)(ws + WS_HB); float* SS = (float*)(ws + WS_SS); \
        float* SSQ = (float*)(ws + WS_SSQ); const float* rope = (const float*)(ws + WS_ROPE); unsigned char* big = ws + WS_BIG; bf16_t* Obuf = (bf16_t*)(big + B_O); const int G = gridDim.x, c = blockIdx.x; \
        (void)Wb; (void)HB; (void)SS; (void)SSQ; (void)rope; (void)big; (void)Obuf; (void)G; (void)c;
#define PH_END   } if (ph + 1 < hi) GRID_BAR(); } ++ph;
#define PH_END_CG } if (ph + 1 < hi) { if (lo < 0) grid.sync();   GRID_BAR(); } } ++ph;
#define PH_END_NOSYNC } } ++ph;

#if PROBE_VARIANT == 2
    for (int i = 0; i < 100; ++i) GRID_BAR();
#endif
    PH_BEGIN_C(0) p0_prologue(wv, P, lds); PH_END_CG

#pragma nounroll
    for (int L = 0; L < 4; ++L) {
#pragma nounroll
        for (int sub = 0; sub < 3; ++sub) {
            if (sub != 1) {
                PH_BEGIN_C(1)
                    bf16_t* wf = Wb + (size_t)(L * 2 + (sub >> 1)) * FFN_SZ;
                    pg8::Gemm g{HB, wf + FFN_WGU, M, 2 * FF, D, D, D}; pg8::StaticOrder<(M) / 256, (2 * FF) / 256> S; S.init(M, 2 * FF, G, c);
#if PROBE_VARIANT == 1
                    if (_rep == 0 && ((PROBE_MASK >> 1) & 1)) pg8::gemm_phase(wv, lds, g, S, EpiNull{(float*)(ws + WS_SSQ)}); else
#endif
                    pg8::gemm_phase(wv, lds, g, S, EpiSwiglu{SS, (bf16_t*)(big + B_HID)});
                PH_END
            } else if ((L & 1) == 0) {
                PH_BEGIN_C(2)
                    bf16_t* wm = Wb + W_MLA + (size_t)(L >> 1) * MLA_SZ;
                    pg8::Gemm g{HB, wm + MLA_WIN, M, 768, D, D, D}; pg8::StaticOrder<(M) / 256, (768) / 256> S; S.init(M, 768, G, c);
                    pg8::gemm_phase(wv, lds, g, S, EpiMlaIn{SS, (bf16_t*)(big + B_CQKV), SSQ, rope, (bf16_t*)(ws + WS_KR)});
                PH_END
                PH_BEGIN_C(3)
                    bf16_t* wm = Wb + W_MLA + (size_t)(L >> 1) * MLA_SZ;
                    bf16_t* CQKV = (bf16_t*)(big + B_CQKV);
                    { pg8::Gemm g{CQKV + 256, wm + MLA_WUQ, M, 1536, 384, 768, 384}; pg8::StaticOrder<(M) / 256, (1536) / 256> S; S.init(M, 1536, G, c);
                      pg8::gemm_phase(wv, lds, g, S, EpiMlaQ{SSQ, (bf16_t*)(big + B_MQ), rope}); }
                PH_END_NOSYNC
                PH_BEGIN_C(3)
                    bf16_t* wm = Wb + W_MLA + (size_t)(L >> 1) * MLA_SZ;
                    bf16_t* CQKV = (bf16_t*)(big + B_CQKV);
                    { pg8::Gemm g{CQKV, wm + MLA_WUKV, M, 1024, 256, 768, 256}; pg8::StaticOrder<(M) / 256, (1024) / 256> S; S.init(M, 1024, G, c);
                      pg8::gemm_phase(wv, lds, g, S, EpiRowStore<12, 0, 1>{SSQ, 1.f / 256.f, (bf16_t*)P.out  , 1024}); }
                PH_END_NOSYNC
                PH_BEGIN_C(3)
                    bf16_t* wm = Wb + W_MLA + (size_t)(L >> 1) * MLA_SZ;
                    bf16_t* CQKV = (bf16_t*)(big + B_CQKV);
                    { pg8::Gemm g{wm + MLA_WUKV + (size_t)1024 * 256, CQKV, 1024, M, 256, 256, 768}; pg8::StaticOrder<(1024) / 256, (M) / 256> S; S.init(1024, M, G, c);
                      pg8::gemm_phase(wv, lds, g, S, EpiColScale<12, 0, 1>{SSQ, 1.f / 256.f, (bf16_t*)(big + B_VT), (size_t)1024}); }
                PH_END
                PH_BEGIN_C(4)
#if PROBE_VARIANT >= 10
                    if (_rep == 0 && ((PROBE_MASK >> 4) & 1)) mla_attn_phase<PROBE_VARIANT - 10>(wv, lds, (const bf16_t*)(big + B_MQ), (const bf16_t*)P.out, (const bf16_t*)(ws + WS_KR), (const bf16_t*)(big + B_VT), Obuf); else
#endif
                    mla_attn_phase<0>(wv, lds, (const bf16_t*)(big + B_MQ), (const bf16_t*)P.out, (const bf16_t*)(ws + WS_KR), (const bf16_t*)(big + B_VT), Obuf);
                PH_END
            } else {
                PH_BEGIN_C(5)
                    bf16_t* wn = Wb + W_NSA + (size_t)(L >> 1) * NSA_SZ;
                    { pg8::Gemm g{HB, wn + NSA_WIN, M, 2304, D, D, D}; pg8::StaticOrder<(M) / 256, (2304) / 256> S; S.init(M, 2304, G, c);
                      pg8::gemm_phase(wv, lds, g, S, EpiNsaIn{SS, (bf16_t*)(big + B_NQ), (bf16_t*)(big + B_SLAB), (float*)(big + B_GATES)}); }
                    { pg8::Gemm g{wn + NSA_WIN + (size_t)2304 * 1024, HB, 512, M, D, D, D}; pg8::StaticOrder<(512) / 256, (M) / 256> S; S.init(512, M, G, c);
                      pg8::gemm_phase(wv, lds, g, S, EpiColScale<16, 0, 4>{SS, 1.f / 1024.f, (bf16_t*)(big + B_VT2), (size_t)512}); }
                PH_END
                PH_BEGIN_C(6)
                    bf16_t* wn = Wb + W_NSA + (size_t)(L >> 1) * NSA_SZ;
                    nsa_compress_phase(wv, lds, (const bf16_t*)(big + B_SLAB), wn, (const float*)(ws + WS_C1) + (L >> 1) * 256, (bf16_t*)(big + B_KCMP), (bf16_t*)(big + B_VCMPT));
                PH_END
                PH_BEGIN_C(7)
                    nsa_attn_phase(wv, lds, (const bf16_t*)(big + B_NQ), (const bf16_t*)(big + B_SLAB), (const bf16_t*)(big + B_VT2), (const float*)(big + B_GATES),
                                   (const bf16_t*)(big + B_KCMP), (const bf16_t*)(big + B_VCMPT), P.in[11], Obuf);
                PH_END
            }
            PH_BEGIN_C(9)
                const bf16_t* rA; const bf16_t* rB; int rK; float ralpha;
                if (sub != 1) { bf16_t* wf = Wb + (size_t)(L * 2 + (sub >> 1)) * FFN_SZ; rA = (const bf16_t*)(big + B_HID); rB = wf + FFN_WD; rK = FF; ralpha = 0.5f; }
                else if ((L & 1) == 0) { rA = Obuf; rB = Wb + W_MLA + (size_t)(L >> 1) * MLA_SZ + MLA_WO; rK = D; ralpha = 1.f; }
                else { rA = Obuf; rB = Wb + W_NSA + (size_t)(L >> 1) * NSA_SZ + NSA_WO; rK = D; ralpha = 1.f; }
                if (_rep == 0 && ((PROBE_MASK >> 9) & 1)) ralpha = 0.f;
                pg8::Gemm g{rA, rB, M, D, rK, rK, rK}; pg8::StaticOrder<(M) / 256, (D) / 256> S; S.init(M, D, G, c);
                pg8::gemm_phase(wv, lds, g, S, EpiResid{HB, SS, ralpha});
            PH_END
        }
    }
    PH_BEGIN_C(8) final_norm_phase(wv, P); PH_END
#undef PH_BEGIN_C
#undef PH_END
}
constexpr int N_PHASES = 1 + 4 * (2 + 4 + 2) + 2 * 2 + 1;

extern "C" void kernel_launch(void* const* d_in, const int* in_sizes, int n_in, void* d_out, int out_size, void* d_ws, size_t ws_size, hipStream_t stream) {
    static int grid = 0;
    if (grid == 0) {
        if (n_in != 26 || out_size != M * D || ws_size < WS_END) { fprintf(stderr, "kernel_launch: unexpected shapes (n_in %d out %d ws %zu need %zu)\n", n_in, out_size, ws_size, (size_t)WS_END); grid = -1; return; }
        int dev = 0, cus = 0, per_cu = 0;
        hipGetDevice(&dev); hipDeviceGetAttribute(&cus, hipDeviceAttributeMultiprocessorCount, dev);
        if (hipFuncSetAttribute((const void*)mega_fwd, hipFuncAttributeMaxDynamicSharedMemorySize, LDS_BYTES) != hipSuccess) { fprintf(stderr, "kernel_launch: hipFuncSetAttribute failed\n"); }
        hipOccupancyMaxActiveBlocksPerMultiprocessor(&per_cu, (const void*)mega_fwd, 512, LDS_BYTES);
        (void)hipGetLastError();
        if (per_cu < 1) per_cu = 1;
        grid = cus * 1;
        if (grid > 256) grid = 256;
        fprintf(stderr, "kernel_launch: grid %d (cus %d per_cu %d)\n", grid, cus, per_cu);
    }
    if (grid < 0) return;
    if (hipMemsetAsync((char*)d_ws + WS_BAR, 0, XCD_BAR_WORDS * 4, stream) != hipSuccess) { fprintf(stderr, "kernel_launch: memset of barrier words failed\n"); return; }
    Params p{};
    for (int i = 0; i < 26; ++i) p.in[i] = (const float*)d_in[i];
    p.out = (float*)d_out; p.ws = (unsigned char*)d_ws;
#if MK_PER_PHASE
    for (int ph = 0; ph < N_PHASES; ++ph) {
        p.ph_lo = ph; p.ph_hi = ph + 1;
        hipLaunchKernelGGL(mega_fwd, dim3(grid), dim3(512), LDS_BYTES, stream, p);
    }
#else
    p.ph_lo = 0; p.ph_hi = N_PHASES;
    void* args[] = {&p};
    hipError_t e = hipLaunchCooperativeKernel((const void*)mega_fwd, dim3(grid), dim3(512), args, LDS_BYTES, stream);
    if (e != hipSuccess) fprintf(stderr, "cooperative launch failed: %s (grid %d)\n", hipGetErrorString(e), grid);
#endif
}
```
